# Optimizing an MI355X kernel written in HIP

```python
import jax, jax.numpy as jnp
from jax import lax
import numpy as np

D_MODEL = 1024
BATCH = 8
SEQ = 2048
DEPTH = 2

CHUNK = 64

D_A = D_MODEL
CONV_A_WIDTH = 31
D_B = D_MODEL
CONV_B_WIDTH = 3
D_C = D_MODEL
POOL_WINDOWS = (2, 4, 8, 16)
N_POOL_GROUPS = len(POOL_WINDOWS)
GROUP_C = D_C // N_POOL_GROUPS
N_BRANCHES = 3
IN_COLS = 2 * D_A + 3 * D_B + D_C + N_BRANCHES * D_MODEL

N_EXPERTS = 16
N_EXPERT_GROUPS = 4
EXPERTS_PER_GROUP = N_EXPERTS // N_EXPERT_GROUPS
TOP_K = 2
D_EXPERT = D_MODEL // 2

LN_EPS = 1e-5
DEEPNORM_ALPHA = (2 * DEPTH) ** 0.25
DEEPNORM_BETA = (8 * DEPTH) ** -0.25

kernel_name = "hybrid_conv_pool_gated_moe_trunk"


def layer_norm(x, g, b):
    x32 = x.astype(jnp.float32)
    mu = jnp.mean(x32, axis=-1, keepdims=True)
    xc = x32 - mu
    var = jnp.mean(xc * xc, axis=-1, keepdims=True)
    y = xc * lax.rsqrt(var + LN_EPS) * g.astype(jnp.float32) + b.astype(jnp.float32)
    return y.astype(x.dtype)


def causal_depthwise_conv(u, w):
    k, c = w.shape
    return lax.conv_general_dilated(
        u, w[:, None, :].astype(u.dtype), window_strides=(1,), padding=[(k - 1, 0)],
        dimension_numbers=("NWC", "WIO", "NWC"), feature_group_count=c)


def multi_scale_pool_minus_self(u):
    t_len = u.shape[1]
    u32 = u.astype(jnp.float32)
    cs = jnp.cumsum(u32, axis=1)
    t_idx = jnp.arange(t_len)
    outs = []
    for g, w in enumerate(POOL_WINDOWS):
        c = cs[..., g * GROUP_C:(g + 1) * GROUP_C]
        lower = jnp.pad(c, ((0, 0), (w, 0), (0, 0)))[:, :t_len]
        count = jnp.minimum(t_idx + 1, w).astype(jnp.float32)[None, :, None]
        outs.append((c - lower) / count - u32[..., g * GROUP_C:(g + 1) * GROUP_C])
    return jnp.concatenate(outs, axis=-1).astype(u.dtype)


def hybrid_mixer(x, w_in, b_in, conv_a_w, conv_a_b, ln_a_g, ln_a_b, w_a_out,
                 conv_b_w, w_b_out, w_c_group, c_scale, w_o, b_o):
    bsz, t_len, _ = x.shape
    proj = jnp.einsum("btd,dc->btc", x, w_in) + b_in
    o1 = 2 * D_A
    o2 = o1 + 3 * D_B
    o3 = o2 + D_C
    a_in, b_part, c_in, gate_in = jnp.split(proj, [o1, o2, o3], axis=-1)

    a_val, a_gate = jnp.split(a_in, 2, axis=-1)
    a = a_val * jax.nn.sigmoid(a_gate)
    a = causal_depthwise_conv(a, conv_a_w) + conv_a_b
    a = jax.nn.silu(layer_norm(a, ln_a_g, ln_a_b))
    y_a = jnp.einsum("btc,cd->btd", a, w_a_out)

    gate_bb, gate_cc, xb = jnp.split(b_part, 3, axis=-1)
    yb = gate_bb * causal_depthwise_conv(gate_cc * xb, conv_b_w)
    y_b = jnp.einsum("btc,cd->btd", yb, w_b_out)

    pooled = multi_scale_pool_minus_self(c_in).reshape(bsz, t_len, N_POOL_GROUPS, GROUP_C)
    y_c = jnp.einsum("btgi,gio->btgo", pooled, w_c_group).reshape(bsz, t_len, D_C) * c_scale

    g = jax.nn.sigmoid(gate_in).reshape(bsz, t_len, N_BRANCHES, D_MODEL)
    merged = g[..., 0, :] * y_a + g[..., 1, :] * y_b + g[..., 2, :] * y_c
    return jnp.einsum("btd,de->bte", merged, w_o) + b_o


def grouped_moe(x, w_router, b_router, w_exp_gate, w_exp_up, w_exp_down):
    bsz, t_len, d = x.shape
    xt = x.reshape(-1, d)
    logits = (xt @ w_router + b_router).astype(jnp.float32)
    probs = jax.nn.softmax(logits, axis=-1)
    grouped = probs.reshape(-1, N_EXPERT_GROUPS, EXPERTS_PER_GROUP)
    group_score = lax.top_k(grouped, TOP_K)[0].sum(-1)
    best_group = jnp.argmax(group_score, axis=-1)
    in_group = jnp.einsum("ng,nge->ne", jax.nn.one_hot(best_group, N_EXPERT_GROUPS, dtype=jnp.float32), grouped)
    top_p, top_i = lax.top_k(in_group, TOP_K)
    top_p = top_p / jnp.sum(top_p, axis=-1, keepdims=True)
    expert_idx = best_group[:, None] * EXPERTS_PER_GROUP + top_i
    combine = jnp.einsum("nk,nke->ne", top_p, jax.nn.one_hot(expert_idx, N_EXPERTS, dtype=jnp.float32)).astype(x.dtype)
    y = jnp.zeros_like(xt)
    for e in range(N_EXPERTS):
        h = jax.nn.silu(xt @ w_exp_gate[e]) * (xt @ w_exp_up[e])
        y = y + combine[:, e:e + 1] * (h @ w_exp_down[e])
    return y.reshape(bsz, t_len, d)


def setup_inputs(seed: int = 0) -> dict:
    key = jax.random.key(seed)
    ks = jax.random.split(key, 24)
    f32 = jnp.float32

    def nrm(k, shape, scale):
        return jax.random.normal(k, shape, f32) * scale

    L = DEPTH
    return {
        "x": nrm(ks[0], (BATCH, SEQ, D_MODEL), 1.0),
        "w_in": nrm(ks[1], (L, D_MODEL, IN_COLS), D_MODEL ** -0.5),
        "b_in": nrm(ks[2], (L, IN_COLS), 0.01),
        "conv_a_w": nrm(ks[3], (L, CONV_A_WIDTH, D_A), CONV_A_WIDTH ** -0.5),
        "conv_a_b": nrm(ks[4], (L, D_A), 0.01),
        "ln_a_g": 1.0 + nrm(ks[5], (L, D_A), 0.01),
        "ln_a_b": nrm(ks[6], (L, D_A), 0.01),
        "w_a_out": nrm(ks[7], (L, D_A, D_MODEL), D_A ** -0.5 * DEEPNORM_BETA),
        "conv_b_w": nrm(ks[8], (L, CONV_B_WIDTH, D_B), CONV_B_WIDTH ** -0.5),
        "w_b_out": nrm(ks[9], (L, D_B, D_MODEL), D_B ** -0.5 * DEEPNORM_BETA),
        "w_c_group": nrm(ks[10], (L, N_POOL_GROUPS, GROUP_C, GROUP_C), GROUP_C ** -0.5 * DEEPNORM_BETA),
        "c_scale": 1.0 + nrm(ks[11], (L, D_C), 0.01),
        "w_o": nrm(ks[12], (L, D_MODEL, D_MODEL), D_MODEL ** -0.5 * DEEPNORM_BETA),
        "b_o": nrm(ks[13], (L, D_MODEL), 0.01),
        "ln1_g": 1.0 + nrm(ks[14], (L, D_MODEL), 0.01),
        "ln1_b": nrm(ks[15], (L, D_MODEL), 0.01),
        "w_router": nrm(ks[16], (D_MODEL, N_EXPERTS), D_MODEL ** -0.5),
        "b_router": nrm(ks[17], (N_EXPERTS,), 0.01),
        "w_exp_gate": nrm(ks[18], (L, N_EXPERTS, D_MODEL, D_EXPERT), D_MODEL ** -0.5),
        "w_exp_up": nrm(ks[19], (L, N_EXPERTS, D_MODEL, D_EXPERT), D_MODEL ** -0.5),
        "w_exp_down": nrm(ks[20], (L, N_EXPERTS, D_EXPERT, D_MODEL), D_EXPERT ** -0.5 * DEEPNORM_BETA),
        "ln2_g": 1.0 + nrm(ks[21], (L, D_MODEL), 0.01),
        "ln2_b": nrm(ks[22], (L, D_MODEL), 0.01),
    }


def reference(x, w_in, b_in, conv_a_w, conv_a_b, ln_a_g, ln_a_b, w_a_out,
              conv_b_w, w_b_out, w_c_group, c_scale, w_o, b_o, ln1_g, ln1_b,
              w_router, b_router, w_exp_gate, w_exp_up, w_exp_down, ln2_g, ln2_b):
    for l in range(DEPTH):
        mix = hybrid_mixer(x, w_in[l], b_in[l], conv_a_w[l], conv_a_b[l], ln_a_g[l], ln_a_b[l],
                           w_a_out[l], conv_b_w[l], w_b_out[l], w_c_group[l], c_scale[l],
                           w_o[l], b_o[l])
        x = layer_norm(DEEPNORM_ALPHA * x + mix, ln1_g[l], ln1_b[l])
        ffn = grouped_moe(x, w_router, b_router, w_exp_gate[l], w_exp_up[l], w_exp_down[l])
        x = layer_norm(DEEPNORM_ALPHA * x + ffn, ln2_g[l], ln2_b[l])
    return x
```

```cpp
#include <hip/hip_runtime.h>
#include <cstdio>
#include <cstdint>
#include <type_traits>


#ifndef DUP_MASK
#define DUP_MASK 0
#endif
#define LAS __attribute__((address_space(3)))
#define GAS __attribute__((address_space(1)))
typedef unsigned short bf16_t;
typedef short bf16x8 __attribute__((ext_vector_type(8)));
typedef float f32x4 __attribute__((ext_vector_type(4)));
typedef float f32x2 __attribute__((ext_vector_type(2)));
typedef unsigned u32x4 __attribute__((ext_vector_type(4)));
typedef unsigned u32x2 __attribute__((ext_vector_type(2)));
typedef int i32x4 __attribute__((ext_vector_type(4)));
typedef signed char q8_t;
typedef GAS unsigned gu32;

constexpr int BATCH = 8, SEQ = 2048, DM = 1024, M = BATCH * SEQ, DEPTH = 2, INC = 9216, NEXP = 16, DE = 512;
constexpr float LN_EPS = 1e-5f;
constexpr float ALPHA = 1.4142135623730951f;
constexpr int NPH = 10;
enum { PH_W = 0, PH_G1A = 1, PH_P2 = 2, PH_G1B = 3, PH_P3 = 4, PH_P4 = 5, PH_LN1 = 6, PH_UP = 7, PH_DN = 8, PH_LN2 = 9 };
enum { IN_X = 0, IN_WIN, IN_BIN, IN_CAW, IN_CAB, IN_LAG, IN_LAB, IN_WA, IN_CBW, IN_WB, IN_WC, IN_CS, IN_WO, IN_BO, IN_L1G, IN_L1B, IN_WR, IN_BR, IN_WG, IN_WU, IN_WD, IN_L2G, IN_L2B, N_IN };

constexpr size_t MiB = 1u << 20;
constexpr size_t WS_CTL = 0;
constexpr size_t CTL_WORDS_BYTES = 262144, WS_ETOK = 262144, ETOK_BYTES = (size_t)NEXP * M * 4, ZERO_BYTES = CTL_WORDS_BYTES + ETOK_BYTES;
constexpr size_t WS_ZERO = 256000;
constexpr size_t WS_TOKINFO = 2 * MiB;
constexpr size_t WS_XS = 3 * MiB;
constexpr size_t WS_WB = 4 * MiB;
constexpr size_t WB_1A = 0, WB_1B = 12 * MiB, WB_WA = 18 * MiB, WB_WBB = 20 * MiB, WB_WC = 22 * MiB, WB_WO = 24 * MiB, WB_UP = 26 * MiB, WB_DN = 58 * MiB, WB_BIAS = 74 * MiB, WB_WS1 = WB_BIAS + 65536, WB_WSUP = WB_BIAS + 131072;
constexpr size_t WS_XB = 80 * MiB;
constexpr size_t WS_PA = 112 * MiB;
constexpr size_t WS_OPS = 240 * MiB;
constexpr size_t WS_END = 336 * MiB;
constexpr size_t PA_H = 0, PA_YS = 40 * MiB;
constexpr int SLOT_ROWS = 36864, MAX_RT = SLOT_ROWS / 256;
constexpr int LDPA = 4096, LDOPS = 1024; constexpr size_t OPS_SEG = (size_t)M * 1024;
constexpr int CW_TMO = 0, CW_CODE = 1, CW_CNT = 1024, CW_BAR = 4096;

constexpr int RING_BYTES = 131072, LDSCTL_OFF = 159744, MISC_OFF = LDSCTL_OFF + 320, LDS_BYTES = 163840;

__device__ __forceinline__ float bf2f(unsigned b) { return __uint_as_float(b << 16); }
__device__ __forceinline__ unsigned f2bf(float f) { unsigned u = __float_as_uint(f); return (u + 0x7fffu + ((u >> 16) & 1u)) >> 16; }
__device__ __forceinline__ unsigned pk2(float lo, float hi) { return f2bf(lo) | (f2bf(hi) << 16); }
__device__ __forceinline__ unsigned cvt_pk_bf16(float lo, float hi) { unsigned r; asm volatile("v_cvt_pk_bf16_f32 %0, %1, %2" : "=v"(r) : "v"(lo), "v"(hi)); return r; }
__device__ __forceinline__ float sigmoidf_(float x) { return __builtin_amdgcn_rcpf(1.0f + __builtin_amdgcn_exp2f(-1.4426950408889634f * x)); }
__device__ __forceinline__ float siluf_(float x) { return x * sigmoidf_(x); }
__device__ __forceinline__ float gate_clamp(float x) { return fmaxf(sigmoidf_(x), 1e-20f); }
template <int CTRL> __device__ __forceinline__ float dppf(float x) { return __builtin_bit_cast(float, __builtin_amdgcn_mov_dpp(__builtin_bit_cast(int, x), CTRL, 0xf, 0xf, true)); }
constexpr int DPP_XOR1 = 0xB1, DPP_XOR2 = 0x4E, DPP_XOR7 = 0x141, DPP_XOR8 = 0x128, DPP_ROR4 = 0x124;
__device__ __forceinline__ float xrow16_sum(float x) {
    auto s = __builtin_amdgcn_permlane16_swap(__float_as_uint(x), __float_as_uint(x), false, false);
    x = __uint_as_float(s[0]) + __uint_as_float(s[1]);
    auto t = __builtin_amdgcn_permlane32_swap(__float_as_uint(x), __float_as_uint(x), false, false);
    return __uint_as_float(t[0]) + __uint_as_float(t[1]);
}
__device__ __forceinline__ float wave_sum(float v) {
    v += dppf<DPP_XOR1>(v); v += dppf<DPP_XOR2>(v); v += dppf<DPP_XOR7>(v); v += dppf<DPP_XOR8>(v);
    return xrow16_sum(v);
}
__device__ __forceinline__ void unpack8(const u32x4 w, float (&f)[8]) {
    f[0] = __uint_as_float(w.x << 16); f[1] = __uint_as_float(w.x & 0xffff0000u); f[2] = __uint_as_float(w.y << 16); f[3] = __uint_as_float(w.y & 0xffff0000u);
    f[4] = __uint_as_float(w.z << 16); f[5] = __uint_as_float(w.z & 0xffff0000u); f[6] = __uint_as_float(w.w << 16); f[7] = __uint_as_float(w.w & 0xffff0000u);
}
__host__ __device__ __forceinline__ int src1a(int n) {
    const int pn = n >> 8, r = n & 255;
    if (pn < 8) return r < 128 ? 128 * pn + r : 1024 + 128 * pn + (r - 128);
    if (pn < 16) { const int q = pn - 8; return r < 128 ? 3072 + 128 * q + r : 4096 + 128 * q + (r - 128); }
    if (pn < 20) return 5120 + 256 * (pn - 16) + r;
    return 2048 + 256 * (pn - 20) + r;
}
struct Route { int e1, e2; float p1; };
__device__ __forceinline__ Route route16(const float (&lg)[16]) {
    float mx = lg[0];
#pragma unroll
    for (int e = 1; e < 16; ++e) mx = fmaxf(mx, lg[e]);
    float pr[16];
#pragma unroll
    for (int e = 0; e < 16; ++e) pr[e] = __expf(lg[e] - mx);
    int bg = 0; float bs = -1.f, ba = 0.f, bb = 0.f, bc = 0.f, bd = 0.f;
#pragma unroll
    for (int g = 0; g < 4; ++g) {
        const float a = pr[4 * g], b = pr[4 * g + 1], c = pr[4 * g + 2], d = pr[4 * g + 3];
        const float m1 = fmaxf(a, b), n1 = fminf(a, b), m2 = fmaxf(c, d), n2 = fminf(c, d);
        const float gs = fmaxf(m1, m2) + fmaxf(fminf(m1, m2), fmaxf(n1, n2));
        if (gs > bs) { bs = gs; bg = g; ba = a; bb = b; bc = c; bd = d; }
    }
    int i1 = 0; float v1 = ba;
    if (bb > v1) { v1 = bb; i1 = 1; } if (bc > v1) { v1 = bc; i1 = 2; } if (bd > v1) { v1 = bd; i1 = 3; }
    int i2 = -1; float v2 = -1.f;
    if (i1 != 0 && ba > v2) { v2 = ba; i2 = 0; } if (i1 != 1 && bb > v2) { v2 = bb; i2 = 1; } if (i1 != 2 && bc > v2) { v2 = bc; i2 = 2; } if (i1 != 3 && bd > v2) { v2 = bd; i2 = 3; }
    Route r; r.e1 = 4 * bg + i1; r.e2 = 4 * bg + i2; r.p1 = v1 / (v1 + v2); return r;
}

#define XB_TMO      128
#define XB_XCNT(j)  (256  + 64 * (j))
#define XB_XSUB(j)  (1280 + 64 * (j))
#define XB_XGEN(j)  (2304 + 64 * (j))
#define XB_TOP      3328
#define XB_TOPGEN   3392
#define XCD_BAR_WORDS 3456
#define XB_SPIN_CAP (1u << 18)
__device__ __forceinline__ unsigned xb_ld(unsigned* p)              { return __hip_atomic_load(p, __ATOMIC_RELAXED, __HIP_MEMORY_SCOPE_AGENT); }
__device__ __forceinline__ unsigned xb_add(unsigned* p, unsigned v) { return __hip_atomic_fetch_add(p, v, __ATOMIC_RELAXED, __HIP_MEMORY_SCOPE_AGENT); }
__device__ __forceinline__ unsigned xb_xcc_id() { return (unsigned)__builtin_amdgcn_s_getreg((3 << 11) | 20) & 0xFu; }
#define XB_SPIN(cond, bar) do { unsigned _sp = 0; while (cond) { __builtin_amdgcn_s_sleep(1); \
    if ((++_sp & 255u) == 0u) { if (xb_ld(&(bar)[XB_TMO])) break; if (_sp > XB_SPIN_CAP) { atomicAdd(&(bar)[XB_TMO], 1u); break; } } } } while (0)
struct XcdBarrier { unsigned* bar; unsigned x; volatile LAS unsigned* st; };
__device__ __forceinline__ XcdBarrier xcd_barrier_post(unsigned* bar, volatile LAS unsigned* st) {
    XcdBarrier b; b.bar = bar; b.x = xb_xcc_id(); b.st = st;
    if (threadIdx.x == 0) (void)xb_add(&bar[XB_XCNT(b.x)], 1u);
    return b;
}
__device__ __forceinline__ void xcd_barrier_complete(unsigned* bar, unsigned x, unsigned& nloc, unsigned& nx) {
    const unsigned G = gridDim.x * gridDim.y * gridDim.z;
    unsigned sum, cnt, mine, sp = 0u;
    for (;;) {
        sum = 0u; cnt = 0u; mine = 0u;
#pragma unroll
        for (unsigned j = 0; j < 16; ++j) { const unsigned c = xb_ld(&bar[XB_XCNT(j)]); sum += c; cnt += (c > 0u) ? 1u : 0u; mine = (j == x) ? c : mine; }
        if (sum == G) break;
        __builtin_amdgcn_s_sleep(1);
        if ((++sp & 255u) == 0u) { if (xb_ld(&bar[XB_TMO])) break; if (sp > XB_SPIN_CAP) { atomicAdd(&bar[XB_TMO], 1u); break; } }
    }
    nloc = mine > 0u ? mine : 1u; nx = cnt > 0u ? cnt : 1u;
}
__device__ __forceinline__ void xcd_barrier(const XcdBarrier& b) {
    asm volatile("s_waitcnt vmcnt(0)" ::: "memory");
    __syncthreads();
    if (threadIdx.x == 0) {
        unsigned* bar = b.bar;
        __builtin_amdgcn_s_waitcnt(0);
        unsigned nloc = b.st[0], nx = b.st[1];
        if (nloc == 0u) { xcd_barrier_complete(bar, b.x, nloc, nx); b.st[0] = nloc; b.st[1] = nx; }
        const unsigned old = xb_add(&bar[XB_XSUB(b.x)], 1u);
        const unsigned gen = old / nloc;
        if (old + 1u == (gen + 1u) * nloc) {
            __builtin_amdgcn_fence(__ATOMIC_RELEASE, "agent");
            asm volatile("s_waitcnt vmcnt(0)" ::: "memory");
            const unsigned og = xb_add(&bar[XB_TOP], 1u);
            const unsigned tg = og / nx;
            if (og + 1u == (tg + 1u) * nx) xb_add(&bar[XB_TOPGEN], 1u);
            else XB_SPIN(xb_ld(&bar[XB_TOPGEN]) == tg, bar);
            __builtin_amdgcn_fence(__ATOMIC_ACQUIRE, "agent");
            xb_add(&bar[XB_XGEN(b.x)], 1u);
            asm volatile("s_waitcnt vmcnt(0)" ::: "memory");
        } else {
            XB_SPIN(xb_ld(&bar[XB_XGEN(b.x)]) == gen, bar);
            __builtin_amdgcn_fence(__ATOMIC_ACQUIRE, "agent");
            asm volatile("s_waitcnt vmcnt(0)" ::: "memory");
        }
    }
    __syncthreads();
}

struct Args { const float* in[N_IN]; float* out; unsigned char* ws; int ph_lo, ph_hi, region, pad1; };
#define CAS __attribute__((address_space(4)))
struct Frame {
    LAS unsigned char* lds; volatile LAS unsigned* MISC;
    int tid, lane, wave, G, bid;
    const CAS Args* ap;
    __device__ __forceinline__ const float* in(int i) const { return ap->in[i]; }
    __device__ __forceinline__ float* out() const { return ap->out; }
    __device__ __forceinline__ unsigned char* ws() const { return ap->ws; }
    __device__ __forceinline__ gu32* ctl() const { return (gu32*)(ap->ws + WS_CTL); }
};
#define LDS_WAIT() asm volatile("s_waitcnt lgkmcnt(0)" ::: "memory")
#define VM_WAIT() asm volatile("s_waitcnt vmcnt(0)" ::: "memory")

namespace pg {
constexpr int BM = 256, BK = 64, HALF = 128, HTB = HALF * BK * 2, STAGE_BYTES = 8 * HTB, NXCD = 8, WGM = 8;
__host__ __device__ __forceinline__ int lds_byte(int r, int c) { const int st = (r >> 4) * 2 + (c >> 5), rr = r & 15, cc = c & 31, ob = rr * 64 + cc * 2; return st * 1024 + (ob ^ (((ob >> 9) & 1) << 5)); }
__host__ __device__ __forceinline__ void stage_rc(int b, int& R, int& C) { const int st = b / 1024, sb = b % 1024, swz = sb ^ (((sb >> 9) & 1) << 5); R = (st >> 1) * 16 + swz / 64; C = (st & 1) * 32 + (swz % 64) / 2; }
__host__ __device__ __forceinline__ int perm32(int rho) { const int n = rho >> 4, i = rho & 15; return 8 * (i >> 2) + 4 * n + (i & 3); }

struct Unit { int pm, pn, e, tb; };
__device__ __forceinline__ bool static_next(int nM, int nN, int G, int c, int i, Unit& u) {
    const int nwg = nM * nN; const long L = (long)i * G + c; if (L >= nwg) return false;
    int wgid = (int)L; { const int q = nwg / NXCD, r = nwg % NXCD, xcd = wgid % NXCD, off = wgid / NXCD; wgid = (xcd < r ? xcd * (q + 1) : r * (q + 1) + (xcd - r) * q) + off; }
    const int nig = WGM * nN, gid = wgid / nig, fm = gid * WGM, gsz = (nM - fm) < WGM ? (nM - fm) : WGM;
    u.pm = fm + ((wgid % nig) % gsz); u.pn = (wgid % nig) / gsz; u.e = 0; u.tb = 0; return true;
}

template <class Prob, class Epi, bool ALIGN_EPI>
__device__ __forceinline__ void gemm_phase(LAS unsigned char* lds, const Prob& P, const Epi& E) {
    int tid_ = threadIdx.x; asm volatile("" : "+v"(tid_));
    const int tid = tid_, wid = __builtin_amdgcn_readfirstlane(tid >> 6), lane = tid & 63, wr = wid >> 2, wc = wid & 3, fr = lane & 15, fq = lane >> 4;
    constexpr int LDA = Prob::LDA, LDB = Prob::LDB;
    constexpr size_t HSTEPA = (size_t)HALF * LDA * 2, HSTEPB = (size_t)HALF * LDB * 2, KSTEP = BK * 2;
    int sR[2], sC[2]; unsigned voffA[2], voffB[2];
#pragma unroll
    for (int i = 0; i < 2; ++i) { stage_rc(tid * 16 + i * 8192, sR[i], sC[i]); const int Rb = Epi::PERM ? ((sR[i] & ~31) + perm32(sR[i] & 31)) : sR[i];
        voffA[i] = (unsigned)(sR[i] * LDA + sC[i]) * 2u; voffB[i] = (unsigned)(Rb * LDB + sC[i]) * 2u; }
    unsigned gc[2][2];
    LAS u32x4* gnl = (LAS u32x4*)(lds + STAGE_BYTES) + tid;
    const unsigned ldsw = (unsigned)wid * 1024u;
    const int aoff = lds_byte(wr * 64 + fr, fq * 8), boff = lds_byte(wc * 32 + fr, fq * 8);
#define PG_SA(b, h) (((b) * 2 + (h)) * HTB)
#define PG_SB(b, h) ((4 + (b) * 2 + (h)) * HTB)
#define PG_GLDS(bufoff, gptr, o0, o1) do { \
        __builtin_amdgcn_global_load_lds((const unsigned*)((const char*)(gptr) + (o0)), (LAS unsigned*)(lds + (bufoff) + ldsw), 16, 0, 0); \
        __builtin_amdgcn_global_load_lds((const unsigned*)((const char*)(gptr) + (o1)), (LAS unsigned*)(lds + (bufoff) + ldsw + 8192), 16, 0, 0); } while (0)
#define PG_STAGE_B(bufoff, gptr) PG_GLDS(bufoff, gptr, voffB[0], voffB[1])
#define PG_STAGE_A(bufoff, gptr, h, NX) do { if constexpr (Prob::GATHER) { PG_GLDS(bufoff, gptr, gc[h][0], gc[h][1]); } \
        else PG_GLDS(bufoff, (const char*)(gptr) + (h) * HSTEPA, voffA[0], voffA[1]); } while (0)
#define PG_LDA(dst, b, h) do { _Pragma("unroll") for (int m = 0; m < 4; ++m) _Pragma("unroll") for (int k = 0; k < 2; ++k) dst[m][k] = *(const LAS bf16x8*)(lds + PG_SA(b, h) + aoff + m * 2048 + k * 1024); } while (0)
#define PG_LDB(dst, b, h) do { _Pragma("unroll") for (int n = 0; n < 2; ++n) _Pragma("unroll") for (int k = 0; k < 2; ++k) dst[n][k] = *(const LAS bf16x8*)(lds + PG_SB(b, h) + boff + n * 2048 + k * 1024); } while (0)
#define PG_MMA(ai, bj, At, Bt) do { __builtin_amdgcn_s_setprio(1); _Pragma("unroll") for (int m = 0; m < 4; ++m) _Pragma("unroll") for (int n = 0; n < 2; ++n) _Pragma("unroll") for (int k = 0; k < 2; ++k) \
        { if constexpr (Prob::I8) acc[ai][bj][m][n] = __builtin_amdgcn_mfma_i32_16x16x64_i8(__builtin_bit_cast(i32x4, Bt[n][k]), __builtin_bit_cast(i32x4, At[m][k]), acc[ai][bj][m][n], 0, 0, 0); \
          else acc[ai][bj][m][n] = __builtin_amdgcn_mfma_f32_16x16x32_bf16(Bt[n][k], At[m][k], acc[ai][bj][m][n], 0, 0, 0); } __builtin_amdgcn_s_setprio(0); } while (0)
#define PG_WAIT_V(n) asm volatile("s_waitcnt vmcnt(" #n ")" ::: "memory")
#define PG_WAIT_L(n) asm volatile("s_waitcnt lgkmcnt(" #n ")" ::: "memory")
#define PG_BAR __builtin_amdgcn_s_barrier()
#define PG_SCHED __builtin_amdgcn_sched_barrier(0)
#define PG_GOFF(dst, u) do { if constexpr (Prob::GATHER) { int t_ = tid; asm volatile("" : "+v"(t_));   \
        _Pragma("unroll") for (int i = 0; i < 2; ++i) { int R_, C_; stage_rc(t_ * 16 + i * 8192, R_, C_); _Pragma("unroll") for (int h = 0; h < 2; ++h) \
        dst[h][i] = (unsigned)(P.tok(u, h * HALF + R_) * LDA + C_) * 2u; } } } while (0)
    Unit cur, nxt; int ui = 0;
    if (!P.next(0, cur)) return;
    typedef typename Prob::AccT AccT;
    AccT acc[2][2][4][2];
#pragma unroll
    for (int a = 0; a < 2; ++a)
#pragma unroll
        for (int b = 0; b < 2; ++b)
#pragma unroll
            for (int m = 0; m < 4; ++m)
#pragma unroll
                for (int n = 0; n < 2; ++n) acc[a][b][m][n] = (AccT){0, 0, 0, 0};
    bf16x8 At[4][2], B0[2][2], B1[2][2];
    PG_GOFF(gc, cur);
    {
        const char* cA0 = P.a_tile(cur, 0); const char* cB0 = P.b_tile(cur, 0); const char* cA1 = P.a_tile(cur, 1); const char* cB1 = P.b_tile(cur, 1);
        PG_STAGE_B(PG_SB(0, 0), cB0); PG_STAGE_B(PG_SB(0, 1), cB0 + HSTEPB); PG_STAGE_A(PG_SA(0, 0), cA0, 0, false); PG_STAGE_A(PG_SA(0, 1), cA0, 1, false);
        if (wr == 1) PG_BAR;
        PG_WAIT_V(2); PG_BAR;
        PG_STAGE_B(PG_SB(1, 0), cB1); PG_STAGE_A(PG_SA(1, 0), cA1, 0, false); PG_STAGE_B(PG_SB(1, 1), cB1 + HSTEPB);
        PG_WAIT_V(6); PG_BAR;
    }
    for (;;) {
        const bool has_next = P.next(ui + 1, nxt);
        if (!has_next) nxt = cur;
        if constexpr (Prob::GATHER) { if (has_next) { unsigned gn[2][2]; PG_GOFF(gn, nxt); *gnl = (u32x4){gn[0][0], gn[0][1], gn[1][0], gn[1][1]}; } }
        const int nt = P.nt(cur);
        for (int t = 0; t < nt; t += 2) {
            const bool last = (t == nt - 2);
            const char* a1 = P.a_tile(cur, t + 1);
            const char* a2 = last ? P.a_tile(nxt, 0) : P.a_tile(cur, t + 2); const char* b2 = last ? P.b_tile(nxt, 0) : P.b_tile(cur, t + 2);
            const char* a3 = last ? P.a_tile(nxt, 1) : P.a_tile(cur, t + 3); const char* b3 = last ? P.b_tile(nxt, 1) : P.b_tile(cur, t + 3);
            PG_LDB(B0, 0, 0); PG_LDB(B1, 0, 1); PG_SCHED; PG_LDA(At, 0, 0); PG_STAGE_A(PG_SA(1, 1), a1, 1, false);
            if constexpr (Prob::GATHER) { if (last && has_next) { const u32x4 g_ = *gnl; gc[0][0] = g_.x; gc[0][1] = g_.y; gc[1][0] = g_.z; gc[1][1] = g_.w; } }
            PG_WAIT_V(8); PG_WAIT_L(0); PG_BAR; PG_MMA(0, 0, At, B0); PG_MMA(0, 1, At, B1); PG_BAR; PG_SCHED;
            PG_LDA(At, 0, 1); PG_STAGE_B(PG_SB(0, 0), b2); PG_STAGE_B(PG_SB(0, 1), b2 + HSTEPB); PG_STAGE_A(PG_SA(0, 0), a2, 0, last);
            PG_WAIT_V(8); PG_WAIT_L(0); PG_BAR; PG_MMA(1, 0, At, B0); PG_MMA(1, 1, At, B1); PG_BAR; PG_SCHED;
            PG_LDB(B0, 1, 0); PG_LDB(B1, 1, 1); PG_SCHED; PG_LDA(At, 1, 0); PG_STAGE_A(PG_SA(0, 1), a2, 1, last);
            PG_WAIT_V(8); PG_WAIT_L(0); PG_BAR; PG_MMA(0, 0, At, B0); PG_MMA(0, 1, At, B1); PG_BAR; PG_SCHED;
            PG_LDA(At, 1, 1); PG_STAGE_B(PG_SB(1, 0), b3); PG_STAGE_B(PG_SB(1, 1), b3 + HSTEPB); PG_STAGE_A(PG_SA(1, 0), a3, 0, last);
            PG_WAIT_V(8); PG_WAIT_L(0); PG_BAR; PG_MMA(1, 0, At, B0); PG_MMA(1, 1, At, B1); PG_BAR; PG_SCHED;
            if constexpr (Prob::NSEG > 1) { const int sg = P.seg_end(t + 2); if (sg >= 0) E.mid(acc, cur, sg, wr, wc, fr, fq); }
        }
        if constexpr (ALIGN_EPI) { if (wr == 0) PG_BAR; }
        E(acc, cur, wr, wc, fr, fq);
        if (!has_next) break;
#pragma unroll
        for (int a = 0; a < 2; ++a)
#pragma unroll
            for (int b = 0; b < 2; ++b)
#pragma unroll
                for (int m = 0; m < 4; ++m)
#pragma unroll
                    for (int n = 0; n < 2; ++n) acc[a][b][m][n] = (AccT){0, 0, 0, 0};
        cur = nxt; ++ui;
        if constexpr (ALIGN_EPI) { if (wr == 1) PG_BAR; }
    }
    PG_WAIT_V(0);
    if constexpr (!ALIGN_EPI) { if (wr == 0) PG_BAR; }
    PG_BAR;
#undef PG_SA
#undef PG_SB
#undef PG_GLDS
#undef PG_STAGE_A
#undef PG_STAGE_B
#undef PG_LDA
#undef PG_LDB
#undef PG_MMA
#undef PG_WAIT_V
#undef PG_WAIT_L
#undef PG_BAR
#undef PG_SCHED
#undef PG_GOFF
}

struct ProbDense {
    static constexpr int LDA = 1024, LDB = 1024, NSEG = 1; static constexpr bool GATHER = false, I8 = false; typedef f32x4 AccT;
    const char* A; const char* Bt; int nN, G, c;
    __device__ __forceinline__ bool next(int i, Unit& u) const { return static_next(M / 256, nN, G, c, i, u); }
    __device__ __forceinline__ int nt(const Unit&) const { return 16; }
    __device__ __forceinline__ const char* a_tile(const Unit& u, int t) const { return A + (size_t)u.pm * (256 * LDA * 2) + t * 128; }
    __device__ __forceinline__ const char* b_tile(const Unit& u, int t) const { return Bt + (size_t)u.pn * (256 * LDB * 2) + t * 128; }
    __device__ __forceinline__ int tok(const Unit&, int) const { return 0; }
    __device__ __forceinline__ int seg_end(int) const { return -1; }
};
struct ProbDenseQ {
    static constexpr int LDA = 512, LDB = 512, NSEG = 1; static constexpr bool GATHER = false, I8 = true; typedef i32x4 AccT;
    const char* A; const char* Bt; int nN, G, c;
    __device__ __forceinline__ bool next(int i, Unit& u) const { return static_next(M / 256, nN, G, c, i, u); }
    __device__ __forceinline__ int nt(const Unit&) const { return 8; }
    __device__ __forceinline__ const char* a_tile(const Unit& u, int t) const { return A + (size_t)u.pm * (256 * LDA * 2) + t * 128; }
    __device__ __forceinline__ const char* b_tile(const Unit& u, int t) const { return Bt + (size_t)u.pn * (256 * LDB * 2) + t * 128; }
    __device__ __forceinline__ int tok(const Unit&, int) const { return 0; }
    __device__ __forceinline__ int seg_end(int) const { return -1; }
};
struct ProbP3 {
    static constexpr int LDA = LDOPS, LDB = 1024, NSEG = 3; static constexpr bool GATHER = false, I8 = false; typedef f32x4 AccT;
    const char* A; const char* Wa; const char* Wb; const char* Wc; int G, c;
    __device__ __forceinline__ bool next(int i, Unit& u) const { return static_next(M / 256, 4, G, c, i, u); }
    __device__ __forceinline__ int nt(const Unit&) const { return 36; }
    __device__ __forceinline__ const char* a_tile(const Unit& u, int t) const {
        const char* base = A + (size_t)u.pm * (256 * LDA * 2);
        return t < 16 ? base + t * 128 : (t < 32 ? base + OPS_SEG * 2 + (t - 16) * 128 : base + 2 * OPS_SEG * 2 + (256 * u.pn) * 2 + (t - 32) * 128); }
    __device__ __forceinline__ const char* b_tile(const Unit& u, int t) const {
        const size_t ro = (size_t)u.pn * (256 * LDB * 2);
        return t < 16 ? Wa + ro + t * 128 : (t < 32 ? Wb + ro + (t - 16) * 128 : Wc + ro + (256 * u.pn) * 2 + (t - 32) * 128); }
    __device__ __forceinline__ int tok(const Unit&, int) const { return 0; }
    __device__ __forceinline__ int seg_end(int t2) const { return t2 == 16 ? 0 : (t2 == 32 ? 1 : -1); }
};
template <int LDA_, int LDB_, int NT_, bool GATHER_, int REP = 1, bool I8_ = false> struct ProbMoe {
    static constexpr int LDA = LDA_, LDB = LDB_, NSEG = 1; static constexpr bool GATHER = GATHER_, I8 = I8_; typedef typename std::conditional<I8_, i32x4, f32x4>::type AccT;
    const char* A; const char* Bt; const int* etok; const volatile LAS int* pref; int G, c;
    __device__ __forceinline__ bool next(int i, Unit& u) const {
        const long L = (long)i * G + c; const int NT = pref[16]; if (L >= 4L * NT * REP) return false;
        const int rtg = (int)(L >> 2) % NT; u.pm = rtg; u.pn = (int)(L & 3); int e = 0;
#pragma unroll
        for (int j = 1; j < 16; ++j) e += (rtg >= pref[j]) ? 1 : 0;
        u.e = e; u.tb = e * M + (rtg - pref[e]) * 256; return true; }
    __device__ __forceinline__ int nt(const Unit&) const { return NT_; }
    __device__ __forceinline__ const char* a_tile(const Unit& u, int t) const { return GATHER ? A + t * 128 : A + (size_t)u.pm * (256 * LDA * 2) + t * 128; }
    __device__ __forceinline__ const char* b_tile(const Unit& u, int t) const { return Bt + ((size_t)u.e * 1024 + (size_t)u.pn * 256) * (LDB * 2) + t * 128; }
    __device__ __forceinline__ int tok(const Unit& u, int r) const { return etok[u.tb + r]; }
    __device__ __forceinline__ int seg_end(int) const { return -1; }
};

__device__ __forceinline__ void st_bf16x8(bf16_t* p, const f32x4 v0, const f32x4 v1) {
    u32x4 w; w.x = cvt_pk_bf16(v0[0], v0[1]); w.y = cvt_pk_bf16(v0[2], v0[3]); w.z = cvt_pk_bf16(v1[0], v1[1]); w.w = cvt_pk_bf16(v1[2], v1[3]); *(u32x4*)p = w; }
__device__ __forceinline__ f32x4 cvt4(const i32x4 a) { return (f32x4){(float)a[0], (float)a[1], (float)a[2], (float)a[3]}; }
struct EpiG1aQ {
    static constexpr bool PERM = true; bf16_t* PA; const float* bias; const float* ws; const float* xs;
    __device__ __forceinline__ void operator()(const i32x4 (&acc)[2][2][4][2], const Unit& u, int wr, int wc, int fr, int fq) const {
        const int row0 = u.pm * BM + wr * 64 + fr, j0 = wc * 32 + 8 * fq; const float* bp = bias + u.pn * 256 + j0; const float* sp = ws + u.pn * 256 + j0;
        f32x4 bv[2][2], cs[2][2];
#pragma unroll
        for (int bj = 0; bj < 2; ++bj)
#pragma unroll
            for (int n = 0; n < 2; ++n) { bv[bj][n] = *(const f32x4*)(bp + bj * HALF + 4 * n); cs[bj][n] = *(const f32x4*)(sp + bj * HALF + 4 * n); }
        float rsv[2][4];
#pragma unroll
        for (int ai = 0; ai < 2; ++ai)
#pragma unroll
            for (int m = 0; m < 4; ++m) rsv[ai][m] = xs[row0 + ai * HALF + m * 16];
        if (u.pn < 16) {
            const bool glu = u.pn < 8; const int oc = (glu ? 128 * u.pn : 1024 + 128 * (u.pn - 8)) + j0;
#pragma unroll
            for (int ai = 0; ai < 2; ++ai)
#pragma unroll
                for (int m = 0; m < 4; ++m) { const int row = row0 + ai * HALF + m * 16; const float rs = rsv[ai][m]; bf16_t* rowp = PA + (size_t)row * LDPA + oc; f32x4 o[2];
#pragma unroll
                    for (int n = 0; n < 2; ++n) { const f32x4 v = cvt4(acc[ai][0][m][n]) * (cs[0][n] * rs) + bv[0][n], g = cvt4(acc[ai][1][m][n]) * (cs[1][n] * rs) + bv[1][n];
#pragma unroll
                        for (int e = 0; e < 4; ++e) o[n][e] = glu ? v[e] * sigmoidf_(g[e]) : v[e] * g[e]; }
                    st_bf16x8(rowp, o[0], o[1]); }
        } else {
            const int oc = (u.pn < 20 ? 2048 + 256 * (u.pn - 16) : 3072 + 256 * (u.pn - 20)) + j0;
#pragma unroll
            for (int ai = 0; ai < 2; ++ai)
#pragma unroll
                for (int m = 0; m < 4; ++m) { const int row = row0 + ai * HALF + m * 16; const float rs = rsv[ai][m]; bf16_t* rowp = PA + (size_t)row * LDPA + oc;
#pragma unroll
                    for (int bj = 0; bj < 2; ++bj) st_bf16x8(rowp + bj * HALF, cvt4(acc[ai][bj][m][0]) * (cs[bj][0] * rs) + bv[bj][0], cvt4(acc[ai][bj][m][1]) * (cs[bj][1] * rs) + bv[bj][1]); }
        }
    }
};
struct EpiG1bQ {
    static constexpr bool PERM = true; bf16_t* PA; const float* bias; const float* ws; const float* xs;
    __device__ __forceinline__ void operator()(const i32x4 (&acc)[2][2][4][2], const Unit& u, int wr, int wc, int fr, int fq) const {
        const int row0 = u.pm * BM + wr * 64 + fr, c0 = u.pn * 256 + wc * 32 + 8 * fq;
        f32x4 bv[2][2], cs[2][2];
#pragma unroll
        for (int bj = 0; bj < 2; ++bj)
#pragma unroll
            for (int n = 0; n < 2; ++n) { bv[bj][n] = *(const f32x4*)(bias + c0 + bj * HALF + 4 * n); cs[bj][n] = *(const f32x4*)(ws + c0 + bj * HALF + 4 * n); }
        float rsv[2][4];
#pragma unroll
        for (int ai = 0; ai < 2; ++ai)
#pragma unroll
            for (int m = 0; m < 4; ++m) rsv[ai][m] = xs[row0 + ai * HALF + m * 16];
#pragma unroll
        for (int ai = 0; ai < 2; ++ai)
#pragma unroll
            for (int m = 0; m < 4; ++m) { const int row = row0 + ai * HALF + m * 16; const float rs = rsv[ai][m]; bf16_t* rowp = PA + (size_t)row * LDPA + c0;
#pragma unroll
                for (int bj = 0; bj < 2; ++bj) { f32x4 o[2];
#pragma unroll
                    for (int n = 0; n < 2; ++n) { const f32x4 v = cvt4(acc[ai][bj][m][n]) * (cs[bj][n] * rs) + bv[bj][n];
#pragma unroll
                        for (int e = 0; e < 4; ++e) o[n][e] = gate_clamp(v[e]); }
                    st_bf16x8(rowp + bj * HALF, o[0], o[1]); } }
    }
};
struct EpiUpQ {
    static constexpr bool PERM = true; bf16_t* H; const float* ws; const float* xs; const int* etok;
    __device__ __forceinline__ void operator()(const i32x4 (&acc)[2][2][4][2], const Unit& u, int wr, int wc, int fr, int fq) const {
        const int rl0 = wr * 64 + fr, j0 = wc * 32 + 8 * fq, oc = 128 * u.pn + j0; const float* sp = ws + u.e * 1024 + u.pn * 256 + j0;
        f32x4 cs[2][2];
#pragma unroll
        for (int bj = 0; bj < 2; ++bj)
#pragma unroll
            for (int n = 0; n < 2; ++n) cs[bj][n] = *(const f32x4*)(sp + bj * HALF + 4 * n);
        int tk[2][4]; float rsv[2][4];
#pragma unroll
        for (int ai = 0; ai < 2; ++ai)
#pragma unroll
            for (int m = 0; m < 4; ++m) tk[ai][m] = etok[u.tb + rl0 + ai * HALF + m * 16];
#pragma unroll
        for (int ai = 0; ai < 2; ++ai)
#pragma unroll
            for (int m = 0; m < 4; ++m) rsv[ai][m] = xs[tk[ai][m]];
#pragma unroll
        for (int ai = 0; ai < 2; ++ai)
#pragma unroll
            for (int m = 0; m < 4; ++m) { const int rl = rl0 + ai * HALF + m * 16; const float rs = rsv[ai][m]; f32x4 o[2];
#pragma unroll
                for (int n = 0; n < 2; ++n) { const f32x4 g = cvt4(acc[ai][0][m][n]) * (cs[0][n] * rs), up = cvt4(acc[ai][1][m][n]) * (cs[1][n] * rs);
#pragma unroll
                    for (int e = 0; e < 4; ++e) o[n][e] = siluf_(g[e]) * up[e]; }
                st_bf16x8(H + (size_t)(u.pm * BM + rl) * DE + oc, o[0], o[1]); }
    }
};
struct EpiG1a {
    static constexpr bool PERM = true; bf16_t* PA; const float* bias;
    __device__ __forceinline__ void operator()(const f32x4 (&acc)[2][2][4][2], const Unit& u, int wr, int wc, int fr, int fq) const {
        const int row0 = u.pm * BM + wr * 64 + fr, j0 = wc * 32 + 8 * fq; const float* bp = bias + u.pn * 256 + j0;
        f32x4 bv[2][2];
#pragma unroll
        for (int bj = 0; bj < 2; ++bj)
#pragma unroll
            for (int n = 0; n < 2; ++n) bv[bj][n] = *(const f32x4*)(bp + bj * HALF + 4 * n);
        if (u.pn < 16) {
            const bool glu = u.pn < 8; const int oc = (glu ? 128 * u.pn : 1024 + 128 * (u.pn - 8)) + j0;
#pragma unroll
            for (int ai = 0; ai < 2; ++ai)
#pragma unroll
                for (int m = 0; m < 4; ++m) { bf16_t* rowp = PA + (size_t)(row0 + ai * HALF + m * 16) * LDPA + oc; f32x4 o[2];
#pragma unroll
                    for (int n = 0; n < 2; ++n) { const f32x4 v = acc[ai][0][m][n] + bv[0][n], g = acc[ai][1][m][n] + bv[1][n];
#pragma unroll
                        for (int e = 0; e < 4; ++e) o[n][e] = glu ? v[e] * sigmoidf_(g[e]) : v[e] * g[e]; }
                    st_bf16x8(rowp, o[0], o[1]); }
        } else {
            const int oc = (u.pn < 20 ? 2048 + 256 * (u.pn - 16) : 3072 + 256 * (u.pn - 20)) + j0;
#pragma unroll
            for (int ai = 0; ai < 2; ++ai)
#pragma unroll
                for (int m = 0; m < 4; ++m) { bf16_t* rowp = PA + (size_t)(row0 + ai * HALF + m * 16) * LDPA + oc;
#pragma unroll
                    for (int bj = 0; bj < 2; ++bj) st_bf16x8(rowp + bj * HALF, acc[ai][bj][m][0] + bv[bj][0], acc[ai][bj][m][1] + bv[bj][1]); }
        }
    }
};
struct EpiG1b {
    static constexpr bool PERM = true; bf16_t* PA; const float* bias;
    __device__ __forceinline__ void operator()(const f32x4 (&acc)[2][2][4][2], const Unit& u, int wr, int wc, int fr, int fq) const {
        const int row0 = u.pm * BM + wr * 64 + fr, c0 = u.pn * 256 + wc * 32 + 8 * fq;
        f32x4 bv[2][2];
#pragma unroll
        for (int bj = 0; bj < 2; ++bj)
#pragma unroll
            for (int n = 0; n < 2; ++n) bv[bj][n] = *(const f32x4*)(bias + c0 + bj * HALF + 4 * n);
#pragma unroll
        for (int ai = 0; ai < 2; ++ai)
#pragma unroll
            for (int m = 0; m < 4; ++m) { bf16_t* rowp = PA + (size_t)(row0 + ai * HALF + m * 16) * LDPA + c0;
#pragma unroll
                for (int bj = 0; bj < 2; ++bj) { f32x4 o[2];
#pragma unroll
                    for (int n = 0; n < 2; ++n) { const f32x4 v = acc[ai][bj][m][n] + bv[bj][n];
#pragma unroll
                        for (int e = 0; e < 4; ++e) o[n][e] = gate_clamp(v[e]); }
                    st_bf16x8(rowp + bj * HALF, o[0], o[1]); } }
    }
};
struct EpiP3 {
    static constexpr bool PERM = true; const bf16_t* GT; bf16_t* O;
    __device__ __forceinline__ void mid(f32x4 (&acc)[2][2][4][2], const Unit& u, int seg, int wr, int wc, int fr, int fq) const {
        int row0 = u.pm * BM + wr * 64 + fr; asm volatile("" : "+v"(row0)); const int c0 = u.pn * 256 + wc * 32 + 8 * fq;
#pragma unroll
        for (int ai = 0; ai < 2; ++ai) { u32x4 nu[4][2], de[4][2];
#pragma unroll
            for (int m = 0; m < 4; ++m) { const bf16_t* gp = GT + (size_t)(row0 + ai * HALF + m * 16) * LDPA + seg * 1024 + c0;
#pragma unroll
                for (int bj = 0; bj < 2; ++bj) { nu[m][bj] = *(const u32x4*)(gp + bj * HALF); de[m][bj] = *(const u32x4*)(gp + 1024 + bj * HALF); } }
#pragma unroll
            for (int m = 0; m < 4; ++m)
#pragma unroll
                for (int bj = 0; bj < 2; ++bj) { float fn[8], fd[8]; unpack8(nu[m][bj], fn); unpack8(de[m][bj], fd);
#pragma unroll
                    for (int e = 0; e < 4; ++e) { acc[ai][bj][m][0][e] *= fn[e] * __builtin_amdgcn_rcpf(fd[e]); acc[ai][bj][m][1][e] *= fn[4 + e] * __builtin_amdgcn_rcpf(fd[4 + e]); } }
            asm volatile("" ::: "memory"); }
    }
    __device__ __forceinline__ void operator()(const f32x4 (&acc)[2][2][4][2], const Unit& u, int wr, int wc, int fr, int fq) const {
        const int row0 = u.pm * BM + wr * 64 + fr, c0 = u.pn * 256 + wc * 32 + 8 * fq;
#pragma unroll
        for (int ai = 0; ai < 2; ++ai) { u32x4 g2[4][2];
#pragma unroll
            for (int m = 0; m < 4; ++m)
#pragma unroll
                for (int bj = 0; bj < 2; ++bj) g2[m][bj] = *(const u32x4*)(GT + (size_t)(row0 + ai * HALF + m * 16) * LDPA + 2048 + c0 + bj * HALF);
#pragma unroll
            for (int m = 0; m < 4; ++m) { const size_t r = (size_t)(row0 + ai * HALF + m * 16);
#pragma unroll
                for (int bj = 0; bj < 2; ++bj) { float fg[8]; unpack8(g2[m][bj], fg); f32x4 o0, o1;
#pragma unroll
                    for (int e = 0; e < 4; ++e) { o0[e] = acc[ai][bj][m][0][e] * fg[e]; o1[e] = acc[ai][bj][m][1][e] * fg[4 + e]; }
                    st_bf16x8(O + r * 1024 + c0 + bj * HALF, o0, o1); } }
            asm volatile("" ::: "memory"); }
    }
};
struct EpiP4 {
    static constexpr bool PERM = false; const float* res; float* out; const float* bias;
    __device__ __forceinline__ void operator()(const f32x4 (&acc)[2][2][4][2], const Unit& u, int wr, int wc, int fr, int fq) const {
        const int row0 = u.pm * BM + wr * 64 + fr, col0 = u.pn * BM + wc * 32 + 4 * fq;
        f32x4 bv[2][2];
#pragma unroll
        for (int bj = 0; bj < 2; ++bj)
#pragma unroll
            for (int n = 0; n < 2; ++n) bv[bj][n] = *(const f32x4*)(bias + col0 + bj * HALF + n * 16);
#pragma unroll
        for (int ai = 0; ai < 2; ++ai) { f32x4 rs[4][2][2];
#pragma unroll
            for (int m = 0; m < 4; ++m) { const size_t off = (size_t)(row0 + ai * HALF + m * 16) * 1024 + col0;
#pragma unroll
                for (int bj = 0; bj < 2; ++bj)
#pragma unroll
                    for (int n = 0; n < 2; ++n) rs[m][bj][n] = *(const f32x4*)(res + off + bj * HALF + n * 16); }
#pragma unroll
            for (int m = 0; m < 4; ++m) { const size_t off = (size_t)(row0 + ai * HALF + m * 16) * 1024 + col0;
#pragma unroll
                for (int bj = 0; bj < 2; ++bj)
#pragma unroll
                    for (int n = 0; n < 2; ++n) *(f32x4*)(out + off + bj * HALF + n * 16) = rs[m][bj][n] * ALPHA + acc[ai][bj][m][n] + bv[bj][n]; }
            asm volatile("" ::: "memory"); }
    }
};
struct EpiUp {
    static constexpr bool PERM = true; bf16_t* H;
    __device__ __forceinline__ void operator()(const f32x4 (&acc)[2][2][4][2], const Unit& u, int wr, int wc, int fr, int fq) const {
        const int row0 = u.pm * BM + wr * 64 + fr, oc = 128 * u.pn + wc * 32 + 8 * fq;
#pragma unroll
        for (int ai = 0; ai < 2; ++ai)
#pragma unroll
            for (int m = 0; m < 4; ++m) { f32x4 o[2];
#pragma unroll
                for (int n = 0; n < 2; ++n)
#pragma unroll
                    for (int e = 0; e < 4; ++e) o[n][e] = siluf_(acc[ai][0][m][n][e]) * acc[ai][1][m][n][e];
                st_bf16x8(H + (size_t)(row0 + ai * HALF + m * 16) * DE + oc, o[0], o[1]); }
    }
};
struct EpiDown {
    static constexpr bool PERM = true; bf16_t* YS;
    __device__ __forceinline__ void operator()(const f32x4 (&acc)[2][2][4][2], const Unit& u, int wr, int wc, int fr, int fq) const {
        const int row0 = u.pm * BM + wr * 64 + fr, c0 = u.pn * 256 + wc * 32 + 8 * fq;
#pragma unroll
        for (int ai = 0; ai < 2; ++ai)
#pragma unroll
            for (int m = 0; m < 4; ++m) { bf16_t* rowp = YS + (size_t)(row0 + ai * HALF + m * 16) * 1024 + c0;
#pragma unroll
                for (int bj = 0; bj < 2; ++bj) st_bf16x8(rowp + bj * HALF, acc[ai][bj][m][0], acc[ai][bj][m][1]); }
    }
};
}

__device__ __forceinline__ void tr_item(const float* src, int ld, int k0, int n0, bf16_t* dst, int ldd, int drow0, int dcol0, const float* scale, LAS float* scr, int lane) {
#pragma unroll 8
    for (int i = 0; i < 32; ++i) { const int kk = 2 * i + (lane >> 5); scr[kk * 33 + (lane & 31)] = src[(size_t)(k0 + kk) * ld + n0 + (lane & 31)]; }
    LDS_WAIT(); asm volatile("" ::: "memory");
    const int c = lane & 7;
#pragma unroll
    for (int j = 0; j < 4; ++j) { const int n = (lane >> 3) + 8 * j; const LAS float* s = scr + (8 * c) * 33 + n; const float sc = scale ? scale[drow0 + n] : 1.0f;
        u32x4 o; o.x = pk2(s[0 * 33] * sc, s[1 * 33] * sc); o.y = pk2(s[2 * 33] * sc, s[3 * 33] * sc); o.z = pk2(s[4 * 33] * sc, s[5 * 33] * sc); o.w = pk2(s[6 * 33] * sc, s[7 * 33] * sc);
        *(GAS u32x4*)(dst + (size_t)(drow0 + n) * ldd + dcol0 + k0 + 8 * c) = o; }
    LDS_WAIT(); asm volatile("" ::: "memory");
}
__device__ __forceinline__ float wave_max(float v) {
    v = fmaxf(v, dppf<DPP_XOR1>(v)); v = fmaxf(v, dppf<DPP_XOR2>(v)); v = fmaxf(v, dppf<DPP_XOR7>(v)); v = fmaxf(v, dppf<DPP_XOR8>(v));
    auto s = __builtin_amdgcn_permlane16_swap(__float_as_uint(v), __float_as_uint(v), false, false); v = fmaxf(__uint_as_float(s[0]), __uint_as_float(s[1]));
    auto t = __builtin_amdgcn_permlane32_swap(__float_as_uint(v), __float_as_uint(v), false, false); return fmaxf(__uint_as_float(t[0]), __uint_as_float(t[1]));
}
__device__ __forceinline__ unsigned q8pack(float a, float b, float c, float d) {
    const int qa = (int)__builtin_rintf(a), qb = (int)__builtin_rintf(b), qc = (int)__builtin_rintf(c), qd = (int)__builtin_rintf(d);
    return (unsigned)(qa & 0xff) | ((unsigned)(qb & 0xff) << 8) | ((unsigned)(qc & 0xff) << 16) | ((unsigned)qd << 24);
}
__device__ __forceinline__ void store_q8_row(q8_t* qrow, float* xs, const f32x4 (&v)[4], int lane) {
    float am = 0.f;
#pragma unroll
    for (int j = 0; j < 4; ++j) am = fmaxf(am, fmaxf(fmaxf(fabsf(v[j][0]), fabsf(v[j][1])), fmaxf(fabsf(v[j][2]), fabsf(v[j][3]))));
    am = wave_max(am);
    const float inv = am > 0.f ? 127.0f / am : 0.f;
#pragma unroll
    for (int j = 0; j < 4; ++j) *(unsigned*)(qrow + 256 * j + 4 * lane) = q8pack(v[j][0] * inv, v[j][1] * inv, v[j][2] * inv, v[j][3] * inv);
    if (lane == 0) *xs = am > 0.f ? am * (1.0f / 127.0f) : 1.0f;
}
struct Q8Item { const float* src; int ld, n0; q8_t* dst; int drow0; float* wscale; };
__device__ __forceinline__ void q8_load(const Q8Item& I, int tid, f32x4 (&v)[16]) {
    const float* sp = I.src + (size_t)(4 * (tid >> 3)) * I.ld + I.n0 + 4 * (tid & 7);
#pragma unroll
    for (int p = 0; p < 4; ++p)
#pragma unroll
        for (int r = 0; r < 4; ++r) v[4 * p + r] = *(const f32x4*)(sp + (size_t)(256 * p + r) * I.ld);
}
constexpr int Q8_STRIDE = 1040;
__device__ __forceinline__ void q8_quant(Frame& F, const Q8Item& I, const f32x4 (&v)[16]) {
    LAS float* red = (LAS float*)F.lds;
    LAS unsigned char* qT = F.lds + 1024;
    const int tid = F.tid, b = tid & 7;
    f32x4 am = (f32x4){0.f, 0.f, 0.f, 0.f};
#pragma unroll
    for (int i = 0; i < 16; ++i)
#pragma unroll
        for (int c = 0; c < 4; ++c) am[c] = fmaxf(am[c], fabsf(v[i][c]));
#pragma unroll
    for (int c = 0; c < 4; ++c) { float x = am[c]; x = fmaxf(x, dppf<DPP_XOR8>(x));
        auto s1 = __builtin_amdgcn_permlane16_swap(__float_as_uint(x), __float_as_uint(x), false, false); x = fmaxf(__uint_as_float(s1[0]), __uint_as_float(s1[1]));
        auto s2 = __builtin_amdgcn_permlane32_swap(__float_as_uint(x), __float_as_uint(x), false, false); am[c] = fmaxf(__uint_as_float(s2[0]), __uint_as_float(s2[1])); }
    if (F.lane < 8) *(LAS f32x4*)(red + F.wave * 32 + 4 * b) = am;
    LDS_WAIT(); __syncthreads();
    f32x4 inv;
#pragma unroll
    for (int w = 0; w < 8; ++w) { const f32x4 o = *(const LAS f32x4*)(red + w * 32 + 4 * b);
#pragma unroll
        for (int c = 0; c < 4; ++c) am[c] = fmaxf(am[c], o[c]); }
#pragma unroll
    for (int c = 0; c < 4; ++c) inv[c] = am[c] > 0.f ? 127.0f / am[c] : 0.f;
    if (tid < 8) { f32x4 sc;
#pragma unroll
        for (int c = 0; c < 4; ++c) sc[c] = am[c] > 0.f ? am[c] * (1.0f / 127.0f) : 1.0f;
        *(f32x4*)(I.wscale + I.drow0 + 4 * b) = sc; }
#pragma unroll
    for (int p = 0; p < 4; ++p)
#pragma unroll
        for (int c = 0; c < 4; ++c)
            *(LAS unsigned*)(qT + (4 * b + c) * Q8_STRIDE + 4 * ((tid >> 3) + 64 * p)) = q8pack(v[4 * p][c] * inv[c], v[4 * p + 1][c] * inv[c], v[4 * p + 2][c] * inv[c], v[4 * p + 3][c] * inv[c]);
    LDS_WAIT(); __syncthreads();
}
__device__ __forceinline__ void q8_store(Frame& F, const Q8Item& I) {
    const LAS unsigned char* qT = F.lds + 1024;
#pragma unroll
    for (int j = 0; j < 4; ++j) { const int idx = F.tid + 512 * j, n = idx >> 6, ch = idx & 63;
        *(GAS u32x4*)(I.dst + (size_t)(I.drow0 + n) * 1024 + 16 * ch) = *(const LAS u32x4*)(qT + n * Q8_STRIDE + 16 * ch); }
    LDS_WAIT(); __syncthreads();
}
__device__ __forceinline__ void conv_q8(Frame& F, int l, int lo, int hi, int start, int step) {
    unsigned char* wb = F.ws() + WS_WB;
    const float* w_in = F.in(IN_WIN) + (size_t)l * DM * INC; float* ws1 = (float*)(wb + WB_WS1); float* wsup = (float*)(wb + WB_WSUP);
    const float* wg = F.in(IN_WG) + (size_t)l * NEXP * DM * DE; const float* wu = F.in(IN_WU) + (size_t)l * NEXP * DM * DE;
#define Q8_ITEM(I, it) do { if ((it) < 192) I = Q8Item{w_in, INC, src1a(32 * (it)), (q8_t*)(wb + WB_1A), 32 * (it), ws1}; \
        else if ((it) < 288) I = Q8Item{w_in, INC, 6144 + 32 * ((it) - 192), (q8_t*)(wb + WB_1B), 32 * ((it) - 192), ws1 + 6144}; \
        else { const int r_ = (it) - 288, e_ = r_ >> 5, nb_ = r_ & 31, uq_ = nb_ >> 3, rb_ = nb_ & 7; \
            I = Q8Item{(rb_ < 4 ? wg : wu) + (size_t)e_ * DM * DE, DE, 128 * uq_ + 32 * (rb_ & 3), (q8_t*)(wb + WB_UP) + (size_t)e_ * 1024 * 1024, 32 * nb_, wsup + e_ * 1024}; } } while (0)
    f32x4 v[16]; Q8Item cur, nxt; int it = lo + start;
    if (it < hi) { Q8_ITEM(cur, it); q8_load(cur, F.tid, v); }
    for (; it < hi; it += step) {
        q8_quant(F, cur, v);
        const bool more = it + step < hi;
        if (more) { Q8_ITEM(nxt, it + step); q8_load(nxt, F.tid, v); }
        q8_store(F, cur);
        if (more) cur = nxt;
    }
#undef Q8_ITEM
}
constexpr int CW_SQ = 32 * 16, CW_MIX = 3 * CW_SQ + 4 * 32, CW_ALL = CW_MIX + 16 * 256;
__device__ __forceinline__ void conv_wave(Frame& F, int l, int lo, int hi, int start, int step) {
    unsigned char* wb = F.ws() + WS_WB;
    LAS float* scr = (LAS float*)(F.lds + 36864 + F.wave * 8448);
    for (int it = lo + start; it < hi; it += step) {
        int r = it;
        if (r < 3 * CW_SQ) { const int which = r / CW_SQ, q = r % CW_SQ, nb = q >> 4, kb = q & 15;
            const float* src = (which == 0 ? F.in(IN_WA) : (which == 1 ? F.in(IN_WB) : F.in(IN_WO))) + (size_t)l * DM * DM;
            bf16_t* dst = (bf16_t*)(wb + (which == 0 ? WB_WA : (which == 1 ? WB_WBB : WB_WO)));
            tr_item(src, DM, 64 * kb, 32 * nb, dst, 1024, 32 * nb, 0, nullptr, scr, F.lane); continue; } r -= 3 * CW_SQ;
        if (r < 4 * 32) { const int g = r >> 5, q = r & 31, nb = q >> 2, kb = q & 3;
            tr_item(F.in(IN_WC) + ((size_t)l * 4 + g) * 65536, 256, 64 * kb, 32 * nb, (bf16_t*)(wb + WB_WC), 1024, 256 * g + 32 * nb, 256 * g, F.in(IN_CS) + (size_t)l * DM, scr, F.lane); continue; } r -= 4 * 32;
        { const int e = r >> 8, q = r & 255, nb = q >> 3, kb = q & 7;
            tr_item(F.in(IN_WD) + ((size_t)l * NEXP + e) * DE * DM, DM, 64 * kb, 32 * nb, (bf16_t*)(wb + WB_DN) + (size_t)e * 1024 * 512, 512, 32 * nb, 0, nullptr, scr, F.lane); }
    }
}
__device__ __forceinline__ void conv_bias(Frame& F, int l, int start, int step) {
    float* bias = (float*)(F.ws() + WS_WB + WB_BIAS); const float* b_in = F.in(IN_BIN) + (size_t)l * INC;
    for (int i = start; i < INC; i += step) bias[i] = b_in[i < 6144 ? src1a(i) : i];
}
__device__ __forceinline__ void phase_convert(Frame& F, int l) {
    const int gw = F.bid * 8 + F.wave, NGW = F.G * 8;
    conv_q8(F, l, 0, 800, F.bid, F.G);
    conv_wave(F, l, 0, CW_ALL, gw, NGW);
    conv_bias(F, l, F.bid * 512 + F.tid, F.G * 512);
    {   q8_t* xq = (q8_t*)(F.ws() + WS_XB); float* xs = (float*)(F.ws() + WS_XS);
        for (int row = gw; row < M; row += NGW) { const float* xr = F.in(IN_X) + (size_t)row * DM + 4 * F.lane; f32x4 v[4];
#pragma unroll
            for (int j = 0; j < 4; ++j) v[j] = *(const f32x4*)(xr + 256 * j);
            store_q8_row(xq + (size_t)row * DM, xs + row, v, F.lane); }
    }
}
__device__ __forceinline__ bool moe_slack(Frame& F, const volatile LAS int* pref, int& rank, int& count) {
    const int U = 4 * pref[16], rem = U % F.G;
    if (rem == 0) { rank = F.bid; count = F.G; return true; }
    rank = F.bid - rem; count = F.G - rem; return F.bid >= rem;
}

constexpr int P2_IN_BYTES = 46 * 2048, P2_OUT_OFF = P2_IN_BYTES, P2_TILES = M / 16;
__device__ __forceinline__ void p2_stage(Frame& F, const bf16_t* PA, const unsigned char* zero, int tt) {
    const int grow0 = tt * 16, t0 = grow0 & (SEQ - 1);
#pragma unroll
    for (int i = 0; i < 12; ++i) { const int p = F.wave + 8 * i; if (p < 92) { const int r = p >> 1, half = p & 1;
        const unsigned char* src = (t0 - 30 + r >= 0) ? (const unsigned char*)(PA + (size_t)(grow0 - 30 + r) * LDPA) + half * 1024 : zero;
        __builtin_amdgcn_global_load_lds((const unsigned*)(src + F.lane * 16), (LAS unsigned*)(F.lds + p * 1024), 16, 0, 0); } }
}
__device__ __forceinline__ void phase_p2(Frame& F, int l) {
    const bf16_t* PA = (const bf16_t*)(F.ws() + WS_PA); bf16_t* OPS = (bf16_t*)(F.ws() + WS_OPS);
    const unsigned char* zero = F.ws() + WS_ZERO;
    const int tid = F.tid, lane = F.lane, wave = F.wave;
    LAS unsigned char* lds = F.lds;
    const int pc = tid & 127, rg = tid >> 7;
    const int pw = 2 << (pc >> 5);
    const int nrep = (((DUP_MASK) >> PH_P2) & 1) + 1;
    const int tpb = P2_TILES / F.G; const bool contig = tpb * F.G == P2_TILES;
#define P2_TILE(x) (contig ? ((x) % F.G) * tpb + ((x) / F.G) % tpb : ((x) & (P2_TILES - 1)))
    int tt_ = F.bid;
    if (tt_ < P2_TILES * nrep) p2_stage(F, PA, zero, P2_TILE(tt_));
    for (; tt_ < P2_TILES * nrep; tt_ += F.G) { const int tt = P2_TILE(tt_);
        const int grow0 = tt * 16, t0 = grow0 & (SEQ - 1);
        {   const int r0 = 4 * rg, tb = t0 + r0; const bf16_t* prow = PA + (size_t)(grow0 + r0) * LDPA + 8 * pc;
            u32x4 cu[6], cg[4], cc[19];
#pragma unroll
            for (int k = 0; k < 6; ++k) { cu[k] = (u32x4){0u, 0u, 0u, 0u}; if (tb - 2 + k >= 0) cu[k] = *(const u32x4*)(prow + 1024 + (ptrdiff_t)(k - 2) * LDPA); }
#pragma unroll
            for (int k = 0; k < 4; ++k) cg[k] = *(const u32x4*)(prow + 3072 + (size_t)k * LDPA);
#pragma unroll
            for (int k = 0; k < 19; ++k) { cc[k] = (u32x4){0u, 0u, 0u, 0u}; if (k >= 16 - pw && tb - 15 + k >= 0) cc[k] = *(const u32x4*)(prow + 2048 + (ptrdiff_t)(k - 15) * LDPA); }
            float wb3[3][8];
#pragma unroll
            for (int k = 0; k < 3; ++k) { const f32x4 a = *(const f32x4*)(F.in(IN_CBW) + ((size_t)l * 3 + k) * DM + 8 * pc), b = *(const f32x4*)(F.in(IN_CBW) + ((size_t)l * 3 + k) * DM + 8 * pc + 4);
#pragma unroll
                for (int e = 0; e < 4; ++e) { wb3[k][e] = a[e]; wb3[k][4 + e] = b[e]; } }
#pragma unroll
            for (int i = 0; i < 4; ++i) { float u0[8], u1[8], u2[8], gb[8]; unpack8(cu[i], u0); unpack8(cu[i + 1], u1); unpack8(cu[i + 2], u2); unpack8(cg[i], gb); float o[8];
#pragma unroll
                for (int e = 0; e < 8; ++e) o[e] = gb[e] * (wb3[0][e] * u0[e] + wb3[1][e] * u1[e] + wb3[2][e] * u2[e]);
                u32x4 wv; wv.x = pk2(o[0], o[1]); wv.y = pk2(o[2], o[3]); wv.z = pk2(o[4], o[5]); wv.w = pk2(o[6], o[7]);
                *(u32x4*)(OPS + (size_t)(grow0 + r0 + i) * LDOPS + OPS_SEG + 8 * pc) = wv; }
#pragma unroll
            for (int i = 0; i < 4; ++i) { float s[8], self[8], f[8]; unpack8(cc[15 + i], self);
#pragma unroll
                for (int e = 0; e < 8; ++e) s[e] = self[e];
#pragma unroll
                for (int j = 1; j < 16; ++j) { if (j < pw) { unpack8(cc[15 + i - j], f);
#pragma unroll
                    for (int e = 0; e < 8; ++e) s[e] += f[e]; } }
                const int t = tb + i; const float inv = 1.0f / (float)(t + 1 < pw ? t + 1 : pw);
                u32x4 wv; wv.x = pk2(s[0] * inv - self[0], s[1] * inv - self[1]); wv.y = pk2(s[2] * inv - self[2], s[3] * inv - self[3]);
                wv.z = pk2(s[4] * inv - self[4], s[5] * inv - self[5]); wv.w = pk2(s[6] * inv - self[6], s[7] * inv - self[7]);
                *(u32x4*)(OPS + (size_t)(grow0 + r0 + i) * LDOPS + 2 * OPS_SEG + 8 * pc) = wv; }
        }
        f32x2 w[31]; f32x2 cb;
        { const float* cw = F.in(IN_CAW) + (size_t)l * 31 * DM + 2 * tid; asm volatile("" : "+v"(cw));
#pragma unroll
          for (int k = 0; k < 31; ++k) w[k] = *(const f32x2*)(cw + (size_t)k * DM);
          cb = *(const f32x2*)(F.in(IN_CAB) + (size_t)l * DM + 2 * tid); }
        f32x4 lg[4], lb[4];
#pragma unroll
        for (int q = 0; q < 4; ++q) { lg[q] = *(const f32x4*)(F.in(IN_LAG) + (size_t)l * DM + 256 * q + 4 * lane); lb[q] = *(const f32x4*)(F.in(IN_LAB) + (size_t)l * DM + 256 * q + 4 * lane); }
        VM_WAIT(); __syncthreads();
        f32x2 v[46];
#pragma unroll
        for (int r = 0; r < 46; ++r) { const unsigned bits = *(const LAS unsigned*)(lds + r * 2048 + tid * 4); v[r].x = __uint_as_float(bits << 16); v[r].y = __uint_as_float(bits & 0xffff0000u); }
        LDS_WAIT(); __syncthreads();
        if (tt_ + F.G < P2_TILES * nrep) p2_stage(F, PA, zero, P2_TILE(tt_ + F.G));
#pragma unroll
        for (int o = 0; o < 16; ++o) { f32x2 s = cb;
#pragma unroll
            for (int k = 0; k < 31; ++k) s += w[k] * v[o + k];
            *(LAS f32x2*)(lds + P2_OUT_OFF + o * 4096 + tid * 8) = s; }
        LDS_WAIT(); __builtin_amdgcn_s_barrier(); asm volatile("" ::: "memory");
#pragma unroll
        for (int rr = 0; rr < 2; ++rr) { const int r = wave * 2 + rr; f32x4 x[4]; float s = 0.f;
#pragma unroll
            for (int q = 0; q < 4; ++q) { x[q] = *(const LAS f32x4*)(lds + P2_OUT_OFF + r * 4096 + q * 1024 + lane * 16); s += (x[q][0] + x[q][1]) + (x[q][2] + x[q][3]); }
            const float mean = wave_sum(s) * (1.f / DM); float s2 = 0.f;
#pragma unroll
            for (int q = 0; q < 4; ++q) { x[q] = x[q] - mean; s2 += (x[q][0] * x[q][0] + x[q][1] * x[q][1]) + (x[q][2] * x[q][2] + x[q][3] * x[q][3]); }
            const float rstd = 1.f / sqrtf(wave_sum(s2) * (1.f / DM) + LN_EPS);
            bf16_t* orow = OPS + (size_t)(grow0 + r) * LDOPS;
#pragma unroll
            for (int q = 0; q < 4; ++q) { f32x4 y = x[q] * rstd * lg[q] + lb[q]; u32x2 o; o.x = pk2(siluf_(y[0]), siluf_(y[1])); o.y = pk2(siluf_(y[2]), siluf_(y[3]));
                *(u32x2*)(orow + 256 * q + 4 * lane) = o; } }
    }
    VM_WAIT(); __syncthreads();
}

__device__ __forceinline__ void phase_ln1r(Frame& F, int l, bool dry) {
    LAS float* wr_t = (LAS float*)F.lds;
    LAS int* rinfo = (LAS int*)(F.lds + 65536);
    const int tid = F.tid, lane = F.lane, wave = F.wave;
    { const float* wrg = F.in(IN_WR);
      for (int i = tid; i < DM * 16 / 4; i += 512) { const f32x4 v = *(const f32x4*)(wrg + 4 * i); const int c = i >> 2, e0 = (i & 3) * 4;
#pragma unroll
          for (int e = 0; e < 4; ++e) wr_t[(e0 + e) * DM + c] = v[e]; } }
    f32x4 g[4], b[4];
#pragma unroll
    for (int j = 0; j < 4; ++j) { g[j] = *(const f32x4*)(F.in(IN_L1G) + (size_t)l * DM + 256 * j + 4 * lane); b[j] = *(const f32x4*)(F.in(IN_L1B) + (size_t)l * DM + 256 * j + 4 * lane); }
    float br[16];
#pragma unroll
    for (int e = 0; e < 16; ++e) br[e] = F.in(IN_BR)[e];
    __syncthreads();
    q8_t* XQ = (q8_t*)(F.ws() + (dry ? WS_OPS + 64 * MiB : WS_XB)); float* XS = (float*)(F.ws() + (dry ? WS_OPS + 80 * MiB : WS_XS)); float* xo = dry ? (float*)(F.ws() + WS_OPS) : F.out();
    int* etok = (int*)(F.ws() + WS_ETOK); u32x4* tokinfo = (u32x4*)(F.ws() + WS_TOKINFO);
    for (int blk = F.bid; blk < M / 64; blk += F.G) {
        const float* xin = F.out() + ((size_t)blk * 64 + wave * 8) * DM + 4 * lane;
        f32x4 vn[4];
#pragma unroll
        for (int j = 0; j < 4; ++j) vn[j] = *(const f32x4*)(xin + 256 * j);
#pragma unroll 1
        for (int rr = 0; rr < 8; ++rr) { const int rl = wave * 8 + rr; const size_t row = (size_t)blk * 64 + rl;
            f32x4 v[4]; float s = 0.f;
#pragma unroll
            for (int j = 0; j < 4; ++j) { v[j] = vn[j]; s += (v[j][0] + v[j][1]) + (v[j][2] + v[j][3]); }
            { const int rn = rr < 7 ? rr + 1 : 7;
#pragma unroll
              for (int j = 0; j < 4; ++j) vn[j] = *(const f32x4*)(xin + (size_t)rn * DM + 256 * j); }
            const float mean = wave_sum(s) * (1.f / DM); float s2 = 0.f;
#pragma unroll
            for (int j = 0; j < 4; ++j) { v[j] = v[j] - mean; s2 += (v[j][0] * v[j][0] + v[j][1] * v[j][1]) + (v[j][2] * v[j][2] + v[j][3] * v[j][3]); }
            const float rstd = 1.f / sqrtf(wave_sum(s2) * (1.f / DM) + LN_EPS);
#pragma unroll
            for (int j = 0; j < 4; ++j) { v[j] = v[j] * rstd * g[j] + b[j]; *(f32x4*)(xo + row * DM + 256 * j + 4 * lane) = v[j]; }
            store_q8_row(XQ + row * DM, XS + row, v, lane);
            float a[16];
            const LAS float* wrl = wr_t + 4 * lane; asm volatile("" : "+v"(wrl));
#pragma unroll
            for (int e = 0; e < 16; ++e) { float a0 = 0.f;
#pragma unroll
                for (int j = 0; j < 4; ++j) { const f32x4 wv = *(const LAS f32x4*)(wrl + e * DM + 256 * j); a0 += (v[j][0] * wv[0] + v[j][1] * wv[1]) + (v[j][2] * wv[2] + v[j][3] * wv[3]); }
                a[e] = a0; }
            {
                float t8[8], t4[4], t2[2], t1;
                const bool h0 = (lane & 1) != 0, h1 = (lane & 2) != 0;
#pragma unroll
                for (int i = 0; i < 8; ++i) { auto r = __builtin_amdgcn_permlane32_swap(__float_as_uint(a[i]), __float_as_uint(a[8 + i]), false, false); t8[i] = __uint_as_float(r[0]) + __uint_as_float(r[1]); }
#pragma unroll
                for (int i = 0; i < 4; ++i) { auto r = __builtin_amdgcn_permlane16_swap(__float_as_uint(t8[i]), __float_as_uint(t8[4 + i]), false, false); t4[i] = __uint_as_float(r[0]) + __uint_as_float(r[1]); }
#pragma unroll
                for (int i = 0; i < 2; ++i) t2[i] = (h0 ? t4[2 + i] : t4[i]) + dppf<DPP_XOR1>(h0 ? t4[i] : t4[2 + i]);
                t1 = (h1 ? t2[1] : t2[0]) + dppf<DPP_XOR2>(h1 ? t2[0] : t2[1]);
                t1 += dppf<DPP_ROR4>(t1); t1 += dppf<DPP_XOR8>(t1);
                float lgt[16];
#pragma unroll
                for (int e = 0; e < 16; ++e) lgt[e] = __uint_as_float((unsigned)__builtin_amdgcn_readlane((int)__float_as_uint(t1), 32 * (e >> 3) + 16 * ((e >> 2) & 1) + ((e >> 1) & 1) + 2 * (e & 1))) + br[e];
                const Route rt = route16(lgt);
                if (lane == 0) { rinfo[rl * 4 + 0] = rt.e1; rinfo[rl * 4 + 1] = rt.e2; rinfo[rl * 4 + 2] = (int)__float_as_uint(rt.p1); } }
        }
        __syncthreads();
        if (wave == 0 && !dry) {
            const int e1 = rinfo[lane * 4 + 0], e2 = rinfo[lane * 4 + 1]; const unsigned p1b = (unsigned)rinfo[lane * 4 + 2];
            const unsigned long long ltm = (1ull << lane) - 1ull;
            int mycnt = 0, r1 = 0, r2 = 0;
#pragma unroll
            for (int e = 0; e < 16; ++e) { const unsigned long long m1 = __ballot(e1 == e), m2 = __ballot(e2 == e); const int c1 = __popcll(m1), c2 = __popcll(m2);
                if (lane == e) mycnt = c1 + c2;
                if (e1 == e) r1 = __popcll(m1 & ltm);
                if (e2 == e) r2 = c1 + __popcll(m2 & ltm); }
            int base = 0;
            if (lane < 16) base = (int)__hip_atomic_fetch_add((unsigned*)(F.ctl() + CW_CNT + (l * 16 + lane) * 64), (unsigned)mycnt, __ATOMIC_RELAXED, __HIP_MEMORY_SCOPE_AGENT);
            const int pos1 = __shfl(base, e1) + r1, pos2 = __shfl(base, e2) + r2;
            const int tok = blk * 64 + lane;
            etok[e1 * M + pos1] = tok; etok[e2 * M + pos2] = tok;
            u32x4 ti; ti.x = (unsigned)(e1 | (e2 << 8)); ti.y = (unsigned)pos1; ti.z = (unsigned)pos2; ti.w = p1b; tokinfo[tok] = ti;
        }
        __syncthreads();
    }
}
__device__ __forceinline__ void load_pref(Frame& F, int l, volatile LAS int* pref) {
    if (F.tid == 0) { int p = 0;
        for (int e = 0; e < 16; ++e) { pref[e] = p; const unsigned c = __hip_atomic_load((unsigned*)(F.ctl() + CW_CNT + (l * 16 + e) * 64), __ATOMIC_RELAXED, __HIP_MEMORY_SCOPE_AGENT); p += (int)((c + 255u) >> 8); }
        pref[16] = p < MAX_RT ? p : MAX_RT; }
    __syncthreads();
}
__device__ __forceinline__ void phase_ln2(Frame& F, int l, bool dry) {
    volatile LAS int* pref = (volatile LAS int*)(F.lds + MISC_OFF + 64);
    load_pref(F, l, pref);
    const int lane = F.lane;
    f32x4 g[4], b[4];
#pragma unroll
    for (int j = 0; j < 4; ++j) { g[j] = *(const f32x4*)(F.in(IN_L2G) + (size_t)l * DM + 256 * j + 4 * lane); b[j] = *(const f32x4*)(F.in(IN_L2B) + (size_t)l * DM + 256 * j + 4 * lane); }
    const bf16_t* YS = (const bf16_t*)(F.ws() + WS_PA + PA_YS); q8_t* XQ = (q8_t*)(F.ws() + (dry ? WS_OPS + 64 * MiB : WS_XB)); float* XS = (float*)(F.ws() + (dry ? WS_OPS + 80 * MiB : WS_XS)); float* xo = dry ? (float*)(F.ws() + WS_OPS) : F.out(); const u32x4* tokinfo = (const u32x4*)(F.ws() + WS_TOKINFO);
    const int gw = F.bid * 8 + F.wave, NGW = F.G * 8;
    for (int row = gw; row < M; row += NGW) {
        const u32x4 ti = tokinfo[row]; const int e1 = ti.x & 255, e2 = (ti.x >> 8) & 255; const float p1 = __uint_as_float(ti.w), p2 = 1.0f - p1;
        const size_t s1 = (size_t)pref[e1] * 256 + ti.y, s2 = (size_t)pref[e2] * 256 + ti.z;
        float* xr = F.out() + (size_t)row * DM; f32x4 v[4]; float s = 0.f;
#pragma unroll
        for (int j = 0; j < 4; ++j) { const f32x4 x1 = *(const f32x4*)(xr + 256 * j + 4 * lane);
            const u32x2 ya = *(const u32x2*)(YS + s1 * DM + 256 * j + 4 * lane), yb = *(const u32x2*)(YS + s2 * DM + 256 * j + 4 * lane);
            v[j][0] = ALPHA * x1[0] + p1 * bf2f(ya.x & 0xffffu) + p2 * bf2f(yb.x & 0xffffu); v[j][1] = ALPHA * x1[1] + p1 * bf2f(ya.x >> 16) + p2 * bf2f(yb.x >> 16);
            v[j][2] = ALPHA * x1[2] + p1 * bf2f(ya.y & 0xffffu) + p2 * bf2f(yb.y & 0xffffu); v[j][3] = ALPHA * x1[3] + p1 * bf2f(ya.y >> 16) + p2 * bf2f(yb.y >> 16);
            s += (v[j][0] + v[j][1]) + (v[j][2] + v[j][3]); }
        const float mean = wave_sum(s) * (1.f / DM); float s2q = 0.f;
#pragma unroll
        for (int j = 0; j < 4; ++j) { v[j] = v[j] - mean; s2q += (v[j][0] * v[j][0] + v[j][1] * v[j][1]) + (v[j][2] * v[j][2] + v[j][3] * v[j][3]); }
        const float rstd = 1.f / sqrtf(wave_sum(s2q) * (1.f / DM) + LN_EPS);
#pragma unroll
        for (int j = 0; j < 4; ++j) { v[j] = v[j] * rstd * g[j] + b[j]; *(f32x4*)(xo + (size_t)row * DM + 256 * j + 4 * lane) = v[j]; }
        if (l + 1 < DEPTH) store_q8_row(XQ + (size_t)row * DM, XS + row, v, lane);
    }
}

__global__ void __launch_bounds__(512, 2) mk_fwd(Args args) {
    extern __shared__ __attribute__((aligned(16))) unsigned char lds_raw[];
    Frame F;
    F.lds = (LAS unsigned char*)lds_raw; F.MISC = (volatile LAS unsigned*)(F.lds + MISC_OFF);
    F.tid = threadIdx.x; F.lane = F.tid & 63; F.wave = __builtin_amdgcn_readfirstlane(F.tid >> 6); F.G = gridDim.x; F.bid = blockIdx.x;
    const CAS Args* kap = (const CAS Args*)__builtin_amdgcn_kernarg_segment_ptr(); F.ap = kap;
    for (int u = F.tid; u < (LDS_BYTES - LDSCTL_OFF) / 4; u += 512) ((LAS unsigned*)(F.lds + LDSCTL_OFF))[u] = 0u;
    __syncthreads();
    const int lo = kap->ph_lo, hi = kap->ph_hi;
    XcdBarrier bar; bar.bar = (unsigned*)(F.ctl() + CW_BAR) + kap->region * XCD_BAR_WORDS; bar.x = 0; bar.st = nullptr;
    if (hi - lo > 1) bar = xcd_barrier_post((unsigned*)(F.ctl() + CW_BAR) + kap->region * XCD_BAR_WORDS, F.MISC + 8);
#ifndef PHASE_ENABLE
#define PHASE_ENABLE 0x3ff
#endif
#define DUP(id) for (int rep_ = 0; rep_ < (((DUP_MASK) >> (id)) & 1) + 1; ++rep_)
#define IN_(k) (((PHASE_ENABLE >> ((k) - p0)) & 1) && lo <= (k) && (k) < hi)
#define SEAM(k) do { if (lo <= (k) && (k) + 1 < hi) { XcdBarrier b_; b_.st = bar.st; b_.x = __builtin_amdgcn_readfirstlane(bar.x); b_.bar = (unsigned*)(F.ctl() + CW_BAR) + F.ap->region * XCD_BAR_WORDS; asm volatile("" : "+s"(b_.x)); xcd_barrier(b_); if ((DUP_MASK) & 0x400) xcd_barrier(b_); } } while (0)
    volatile LAS int* pref = (volatile LAS int*)(F.lds + MISC_OFF + 64);
#define REFRESH() asm volatile("" : "+s"(kap)); F.ap = kap; { int t_ = threadIdx.x, b_ = __builtin_amdgcn_readfirstlane((int)blockIdx.x), g_ = __builtin_amdgcn_readfirstlane((int)gridDim.x); asm volatile("" : "+v"(t_), "+s"(b_), "+s"(g_)); \
        F.tid = t_; F.lane = t_ & 63; F.wave = __builtin_amdgcn_readfirstlane(t_ >> 6); F.bid = b_; F.G = g_; } unsigned char* ws = F.ws(); unsigned char* wb = ws + WS_WB; (void)wb
#pragma unroll 1
    for (int l = 0; l < DEPTH; ++l) {
        const int p0 = l * NPH;
        if (l == 0 && IN_(p0 + PH_W)) { REFRESH(); DUP(PH_W) phase_convert(F, l); SEAM(p0 + PH_W); }
        if (IN_(p0 + PH_G1A)) { REFRESH();
            pg::ProbDenseQ P{(const char*)(ws + WS_XB), (const char*)(wb + WB_1A), 24, F.G, F.bid}; pg::EpiG1aQ E{(bf16_t*)(ws + WS_PA), (const float*)(wb + WB_BIAS), (const float*)(wb + WB_WS1), (const float*)(ws + WS_XS)};
            DUP(PH_G1A) pg::gemm_phase<pg::ProbDenseQ, pg::EpiG1aQ, true>(F.lds, P, E); SEAM(p0 + PH_G1A); }
        if (IN_(p0 + PH_P2)) { REFRESH(); phase_p2(F, l); SEAM(p0 + PH_P2); }
        if (IN_(p0 + PH_G1B)) { REFRESH();
            pg::ProbDenseQ P{(const char*)(ws + WS_XB), (const char*)(wb + WB_1B), 12, F.G, F.bid}; pg::EpiG1bQ E{(bf16_t*)(ws + WS_PA), (const float*)(wb + WB_BIAS) + 6144, (const float*)(wb + WB_WS1) + 6144, (const float*)(ws + WS_XS)};
            DUP(PH_G1B) pg::gemm_phase<pg::ProbDenseQ, pg::EpiG1bQ, true>(F.lds, P, E); SEAM(p0 + PH_G1B); }
        if (IN_(p0 + PH_P3)) { REFRESH();
            pg::ProbP3 P{(const char*)(ws + WS_OPS), (const char*)(wb + WB_WA), (const char*)(wb + WB_WBB), (const char*)(wb + WB_WC), F.G, F.bid}; pg::EpiP3 E{(const bf16_t*)(ws + WS_PA), (bf16_t*)(ws + WS_XB)};
            DUP(PH_P3) pg::gemm_phase<pg::ProbP3, pg::EpiP3, false>(F.lds, P, E); SEAM(p0 + PH_P3); }
        if (IN_(p0 + PH_P4)) { REFRESH();
            pg::ProbDense P{(const char*)(ws + WS_XB), (const char*)(wb + WB_WO), 4, F.G, F.bid}; pg::EpiP4 E{l == 0 ? F.in(IN_X) : (const float*)F.out(), F.out(), F.in(IN_BO) + (size_t)l * DM};
            pg::gemm_phase<pg::ProbDense, pg::EpiP4, false>(F.lds, P, E); SEAM(p0 + PH_P4); }
        if (IN_(p0 + PH_LN1)) { REFRESH(); if ((DUP_MASK >> PH_LN1) & 1) phase_ln1r(F, l, true); phase_ln1r(F, l, false); SEAM(p0 + PH_LN1); }
        if (IN_(p0 + PH_UP)) { REFRESH();
            load_pref(F, l, pref);
            typedef pg::ProbMoe<512, 512, 8, true, (((DUP_MASK) >> PH_UP) & 1) + 1, true> PU; PU P{(const char*)(ws + WS_XB), (const char*)(wb + WB_UP), (const int*)(ws + WS_ETOK), pref, F.G, F.bid};
            pg::EpiUpQ E{(bf16_t*)(ws + WS_PA + PA_H), (const float*)(wb + WB_WSUP), (const float*)(ws + WS_XS), (const int*)(ws + WS_ETOK)};
            pg::gemm_phase<PU, pg::EpiUpQ, true>(F.lds, P, E);
            if (l + 1 < DEPTH) { int rank, count; if (moe_slack(F, pref, rank, count)) conv_q8(F, l + 1, 0, 288, rank, count); }
            SEAM(p0 + PH_UP); }
        if (IN_(p0 + PH_DN)) { REFRESH();
            load_pref(F, l, pref);
            typedef pg::ProbMoe<512, 512, 8, false> PD; PD P{(const char*)(ws + WS_PA + PA_H), (const char*)(wb + WB_DN), (const int*)(ws + WS_ETOK), pref, F.G, F.bid}; pg::EpiDown E{(bf16_t*)(ws + WS_PA + PA_YS)};
            DUP(PH_DN) pg::gemm_phase<PD, pg::EpiDown, true>(F.lds, P, E);
            if (l + 1 < DEPTH) { int rank, count; if (moe_slack(F, pref, rank, count)) { conv_wave(F, l + 1, 0, CW_MIX, rank * 8 + F.wave, count * 8); conv_bias(F, l + 1, rank * 512 + F.tid, count * 512); } }
            SEAM(p0 + PH_DN); }
        if (IN_(p0 + PH_LN2)) { REFRESH(); if ((DUP_MASK >> PH_LN2) & 1) phase_ln2(F, l, true); phase_ln2(F, l, false);
            if (l + 1 < DEPTH) { __syncthreads(); conv_q8(F, l + 1, 288, 800, F.bid, F.G); conv_wave(F, l + 1, CW_MIX, CW_ALL, F.bid * 8 + F.wave, F.G * 8); }
            SEAM(p0 + PH_LN2); }
    }
#undef IN_
#undef SEAM
}

extern "C" void kernel_launch(void* const* d_in, const int* in_sizes, int n_in, void* d_out, int out_size, void* d_ws, size_t ws_size, hipStream_t stream) {
    static int grid = 0;
    if (grid == 0) {
        if (n_in != N_IN || in_sizes[0] != M * DM || out_size != M * DM || ws_size < WS_END) { fprintf(stderr, "kernel_launch: unexpected shapes (n_in %d, in0 %d, out %d, ws %zu)\n", n_in, n_in > 0 ? in_sizes[0] : -1, out_size, ws_size); grid = -1; return; }
        int dev = 0, cus = 0, per_cu = 0;
        if (hipGetDevice(&dev) != hipSuccess || hipDeviceGetAttribute(&cus, hipDeviceAttributeMultiprocessorCount, dev) != hipSuccess) { grid = -1; return; }
        if (hipFuncSetAttribute((const void*)mk_fwd, hipFuncAttributeMaxDynamicSharedMemorySize, LDS_BYTES) != hipSuccess) { fprintf(stderr, "kernel_launch: hipFuncSetAttribute failed\n"); grid = -1; return; }
        if (hipOccupancyMaxActiveBlocksPerMultiprocessor(&per_cu, (const void*)mk_fwd, 512, LDS_BYTES) != hipSuccess || per_cu < 1) fprintf(stderr, "kernel_launch: occupancy query says %d\n", per_cu);
        (void)hipGetLastError();
        grid = cus;
    }
    if (grid < 0) return;
    (void)hipMemsetAsync((char*)d_ws + WS_CTL, 0, ZERO_BYTES, stream);
    Args a{};
    for (int i = 0; i < N_IN; ++i) a.in[i] = (const float*)d_in[i];
    a.out = (float*)d_out; a.ws = (unsigned char*)d_ws;
    a.ph_lo = 0; a.ph_hi = DEPTH * NPH; a.region = 0;
    hipLaunchKernelGGL(mk_fwd, dim3(grid), dim3(512), LDS_BYTES, stream, a);
}
```

```cpp
#include <hip/hip_runtime.h>
#include <cstdio>
#include <cstdint>
#include <type_traits>


#ifndef DUP_MASK
#define DUP_MASK 0
#endif
#define LAS __attribute__((address_space(3)))
#define GAS __attribute__((address_space(1)))
typedef unsigned short bf16_t;
typedef short bf16x8 __attribute__((ext_vector_type(8)));
typedef float f32x4 __attribute__((ext_vector_type(4)));
typedef float f32x2 __attribute__((ext_vector_type(2)));
typedef unsigned u32x4 __attribute__((ext_vector_type(4)));
typedef unsigned u32x2 __attribute__((ext_vector_type(2)));
typedef int i32x4 __attribute__((ext_vector_type(4)));
typedef signed char q8_t;
typedef GAS unsigned gu32;

constexpr int BATCH = 8, SEQ = 2048, DM = 1024, M = BATCH * SEQ, DEPTH = 2, INC = 9216, NEXP = 16, DE = 512;
constexpr float LN_EPS = 1e-5f;
constexpr float ALPHA = 1.4142135623730951f;
constexpr int NPH = 10;
enum { PH_W = 0, PH_G1A = 1, PH_P2 = 2, PH_G1B = 3, PH_P3 = 4, PH_P4 = 5, PH_LN1 = 6, PH_UP = 7, PH_DN = 8, PH_LN2 = 9 };
enum { IN_X = 0, IN_WIN, IN_BIN, IN_CAW, IN_CAB, IN_LAG, IN_LAB, IN_WA, IN_CBW, IN_WB, IN_WC, IN_CS, IN_WO, IN_BO, IN_L1G, IN_L1B, IN_WR, IN_BR, IN_WG, IN_WU, IN_WD, IN_L2G, IN_L2B, N_IN };

constexpr size_t MiB = 1u << 20;
constexpr size_t WS_CTL = 0;
constexpr size_t CTL_WORDS_BYTES = 262144, WS_ETOK = 262144, ETOK_BYTES = (size_t)NEXP * M * 4, ZERO_BYTES = CTL_WORDS_BYTES + ETOK_BYTES;
constexpr size_t WS_ZERO = 256000;
constexpr size_t WS_TOKINFO = 2 * MiB;
constexpr size_t WS_XS = 3 * MiB;
constexpr size_t WS_WB = 4 * MiB;
constexpr size_t WB_1A = 0, WB_1B = 12 * MiB, WB_WA = 18 * MiB, WB_WBB = 20 * MiB, WB_WC = 22 * MiB, WB_WO = 24 * MiB, WB_UP = 26 * MiB, WB_DN = 58 * MiB, WB_BIAS = 74 * MiB, WB_WS1 = WB_BIAS + 65536, WB_WSUP = WB_BIAS + 131072;
constexpr size_t WS_XB = 80 * MiB;
constexpr size_t WS_PA = 112 * MiB;
constexpr size_t WS_OPS = 240 * MiB;
constexpr size_t WS_END = 336 * MiB;
constexpr size_t PA_H = 0, PA_YS = 40 * MiB;
constexpr int SLOT_ROWS = 36864, MAX_RT = SLOT_ROWS / 256;
constexpr int LDPA = 4096, LDOPS = 1024; constexpr size_t OPS_SEG = (size_t)M * 1024;
constexpr int CW_TMO = 0, CW_CODE = 1, CW_CNT = 1024, CW_BAR = 4096;

constexpr int RING_BYTES = 131072, LDSCTL_OFF = 159744, MISC_OFF = LDSCTL_OFF + 320, LDS_BYTES = 163840;

__device__ __forceinline__ float bf2f(unsigned b) { return __uint_as_float(b << 16); }
__device__ __forceinline__ unsigned f2bf(float f) { unsigned u = __float_as_uint(f); return (u + 0x7fffu + ((u >> 16) & 1u)) >> 16; }
__device__ __forceinline__ unsigned pk2(float lo, float hi) { return f2bf(lo) | (f2bf(hi) << 16); }
__device__ __forceinline__ unsigned cvt_pk_bf16(float lo, float hi) { unsigned r; asm volatile("v_cvt_pk_bf16_f32 %0, %1, %2" : "=v"(r) : "v"(lo), "v"(hi)); return r; }
__device__ __forceinline__ float sigmoidf_(float x) { return __builtin_amdgcn_rcpf(1.0f + __builtin_amdgcn_exp2f(-1.4426950408889634f * x)); }
__device__ __forceinline__ float siluf_(float x) { return x * sigmoidf_(x); }
__device__ __forceinline__ float gate_clamp(float x) { return fmaxf(sigmoidf_(x), 1e-20f); }
template <int CTRL> __device__ __forceinline__ float dppf(float x) { return __builtin_bit_cast(float, __builtin_amdgcn_mov_dpp(__builtin_bit_cast(int, x), CTRL, 0xf, 0xf, true)); }
constexpr int DPP_XOR1 = 0xB1, DPP_XOR2 = 0x4E, DPP_XOR7 = 0x141, DPP_XOR8 = 0x128, DPP_ROR4 = 0x124;
__device__ __forceinline__ float xrow16_sum(float x) {
    auto s = __builtin_amdgcn_permlane16_swap(__float_as_uint(x), __float_as_uint(x), false, false);
    x = __uint_as_float(s[0]) + __uint_as_float(s[1]);
    auto t = __builtin_amdgcn_permlane32_swap(__float_as_uint(x), __float_as_uint(x), false, false);
    return __uint_as_float(t[0]) + __uint_as_float(t[1]);
}
__device__ __forceinline__ float wave_sum(float v) {
    v += dppf<DPP_XOR1>(v); v += dppf<DPP_XOR2>(v); v += dppf<DPP_XOR7>(v); v += dppf<DPP_XOR8>(v);
    return xrow16_sum(v);
}
__device__ __forceinline__ void unpack8(const u32x4 w, float (&f)[8]) {
    f[0] = __uint_as_float(w.x << 16); f[1] = __uint_as_float(w.x & 0xffff0000u); f[2] = __uint_as_float(w.y << 16); f[3] = __uint_as_float(w.y & 0xffff0000u);
    f[4] = __uint_as_float(w.z << 16); f[5] = __uint_as_float(w.z & 0xffff0000u); f[6] = __uint_as_float(w.w << 16); f[7] = __uint_as_float(w.w & 0xffff0000u);
}
__host__ __device__ __forceinline__ int src1a(int n) {
    const int pn = n >> 8, r = n & 255;
    if (pn < 8) return r < 128 ? 128 * pn + r : 1024 + 128 * pn + (r - 128);
    if (pn < 16) { const int q = pn - 8; return r < 128 ? 3072 + 128 * q + r : 4096 + 128 * q + (r - 128); }
    if (pn < 20) return 5120 + 256 * (pn - 16) + r;
    return 2048 + 256 * (pn - 20) + r;
}
struct Route { int e1, e2; float p1; };
__device__ __forceinline__ Route route16(const float (&lg)[16]) {
    float mx = lg[0];
#pragma unroll
    for (int e = 1; e < 16; ++e) mx = fmaxf(mx, lg[e]);
    float pr[16];
#pragma unroll
    for (int e = 0; e < 16; ++e) pr[e] = __expf(lg[e] - mx);
    int bg = 0; float bs = -1.f, ba = 0.f, bb = 0.f, bc = 0.f, bd = 0.f;
#pragma unroll
    for (int g = 0; g < 4; ++g) {
        const float a = pr[4 * g], b = pr[4 * g + 1], c = pr[4 * g + 2], d = pr[4 * g + 3];
        const float m1 = fmaxf(a, b), n1 = fminf(a, b), m2 = fmaxf(c, d), n2 = fminf(c, d);
        const float gs = fmaxf(m1, m2) + fmaxf(fminf(m1, m2), fmaxf(n1, n2));
        if (gs > bs) { bs = gs; bg = g; ba = a; bb = b; bc = c; bd = d; }
    }
    int i1 = 0; float v1 = ba;
    if (bb > v1) { v1 = bb; i1 = 1; } if (bc > v1) { v1 = bc; i1 = 2; } if (bd > v1) { v1 = bd; i1 = 3; }
    int i2 = -1; float v2 = -1.f;
    if (i1 != 0 && ba > v2) { v2 = ba; i2 = 0; } if (i1 != 1 && bb > v2) { v2 = bb; i2 = 1; } if (i1 != 2 && bc > v2) { v2 = bc; i2 = 2; } if (i1 != 3 && bd > v2) { v2 = bd; i2 = 3; }
    Route r; r.e1 = 4 * bg + i1; r.e2 = 4 * bg + i2; r.p1 = v1 / (v1 + v2); return r;
}

#define XB_TMO      128
#define XB_XCNT(j)  (256  + 64 * (j))
#define XB_XSUB(j)  (1280 + 64 * (j))
#define XB_XGEN(j)  (2304 + 64 * (j))
#define XB_TOP      3328
#define XB_TOPGEN   3392
#define XCD_BAR_WORDS 3456
#define XB_SPIN_CAP (1u << 18)
__device__ __forceinline__ unsigned xb_ld(unsigned* p)              { return __hip_atomic_load(p, __ATOMIC_RELAXED, __HIP_MEMORY_SCOPE_AGENT); }
__device__ __forceinline__ unsigned xb_add(unsigned* p, unsigned v) { return __hip_atomic_fetch_add(p, v, __ATOMIC_RELAXED, __HIP_MEMORY_SCOPE_AGENT); }
__device__ __forceinline__ unsigned xb_xcc_id() { return (unsigned)__builtin_amdgcn_s_getreg((3 << 11) | 20) & 0xFu; }
#define XB_SPIN(cond, bar) do { unsigned _sp = 0; while (cond) { __builtin_amdgcn_s_sleep(1); \
    if ((++_sp & 255u) == 0u) { if (xb_ld(&(bar)[XB_TMO])) break; if (_sp > XB_SPIN_CAP) { atomicAdd(&(bar)[XB_TMO], 1u); break; } } } } while (0)
struct XcdBarrier { unsigned* bar; unsigned x; volatile LAS unsigned* st; };
__device__ __forceinline__ XcdBarrier xcd_barrier_post(unsigned* bar, volatile LAS unsigned* st) {
    XcdBarrier b; b.bar = bar; b.x = xb_xcc_id(); b.st = st;
    if (threadIdx.x == 0) (void)xb_add(&bar[XB_XCNT(b.x)], 1u);
    return b;
}
__device__ __forceinline__ void xcd_barrier_complete(unsigned* bar, unsigned x, unsigned& nloc, unsigned& nx) {
    const unsigned G = gridDim.x * gridDim.y * gridDim.z;
    unsigned sum, cnt, mine, sp = 0u;
    for (;;) {
        sum = 0u; cnt = 0u; mine = 0u;
#pragma unroll
        for (unsigned j = 0; j < 16; ++j) { const unsigned c = xb_ld(&bar[XB_XCNT(j)]); sum += c; cnt += (c > 0u) ? 1u : 0u; mine = (j == x) ? c : mine; }
        if (sum == G) break;
        __builtin_amdgcn_s_sleep(1);
        if ((++sp & 255u) == 0u) { if (xb_ld(&bar[XB_TMO])) break; if (sp > XB_SPIN_CAP) { atomicAdd(&bar[XB_TMO], 1u); break; } }
    }
    nloc = mine > 0u ? mine : 1u; nx = cnt > 0u ? cnt : 1u;
}
__device__ __forceinline__ void xcd_barrier(const XcdBarrier& b) {
    asm volatile("s_waitcnt vmcnt(0)" ::: "memory");
    __syncthreads();
    if (threadIdx.x == 0) {
        unsigned* bar = b.bar;
        __builtin_amdgcn_s_waitcnt(0);
        unsigned nloc = b.st[0], nx = b.st[1];
        if (nloc == 0u) { xcd_barrier_complete(bar, b.x, nloc, nx); b.st[0] = nloc; b.st[1] = nx; }
        const unsigned old = xb_add(&bar[XB_XSUB(b.x)], 1u);
        const unsigned gen = old / nloc;
        if (old + 1u == (gen + 1u) * nloc) {
            __builtin_amdgcn_fence(__ATOMIC_RELEASE, "agent");
            asm volatile("s_waitcnt vmcnt(0)" ::: "memory");
            const unsigned og = xb_add(&bar[XB_TOP], 1u);
            const unsigned tg = og / nx;
            if (og + 1u == (tg + 1u) * nx) xb_add(&bar[XB_TOPGEN], 1u);
            else XB_SPIN(xb_ld(&bar[XB_TOPGEN]) == tg, bar);
            __builtin_amdgcn_fence(__ATOMIC_ACQUIRE, "agent");
            xb_add(&bar[XB_XGEN(b.x)], 1u);
            asm volatile("s_waitcnt vmcnt(0)" ::: "memory");
        } else {
            XB_SPIN(xb_ld(&bar[XB_XGEN(b.x)]) == gen, bar);
            __builtin_amdgcn_fence(__ATOMIC_ACQUIRE, "agent");
            asm volatile("s_waitcnt vmcnt(0)" ::: "memory");
        }
    }
    __syncthreads();
}

struct Args { const float* in[N_IN]; float* out; unsigned char* ws; int ph_lo, ph_hi, region, pad1; };
#define CAS __attribute__((address_space(4)))
struct Frame {
    LAS unsigned char* lds; volatile LAS unsigned* MISC;
    int tid, lane, wave, G, bid;
    const CAS Args* ap;
    __device__ __forceinline__ const float* in(int i) const { return ap->in[i]; }
    __device__ __forceinline__ float* out() const { return ap->out; }
    __device__ __forceinline__ unsigned char* ws() const { return ap->ws; }
    __device__ __forceinline__ gu32* ctl() const { return (gu32*)(ap->ws + WS_CTL); }
};
#define LDS_WAIT() asm volatile("s_waitcnt lgkmcnt(0)" ::: "memory")
#define VM_WAIT() asm volatile("s_waitcnt vmcnt(0)" ::: "memory")

namespace pg {
constexpr int BM = 256, BK = 64, HALF = 128, HTB = HALF * BK * 2, STAGE_BYTES = 8 * HTB, NXCD = 8, WGM = 8;
__host__ __device__ __forceinline__ int lds_byte(int r, int c) { const int st = (r >> 4) * 2 + (c >> 5), rr = r & 15, cc = c & 31, ob = rr * 64 + cc * 2; return st * 1024 + (ob ^ (((ob >> 9) & 1) << 5)); }
__host__ __device__ __forceinline__ void stage_rc(int b, int& R, int& C) { const int st = b / 1024, sb = b % 1024, swz = sb ^ (((sb >> 9) & 1) << 5); R = (st >> 1) * 16 + swz / 64; C = (st & 1) * 32 + (swz % 64) / 2; }
__host__ __device__ __forceinline__ int perm32(int rho) { const int n = rho >> 4, i = rho & 15; return 8 * (i >> 2) + 4 * n + (i & 3); }

struct Unit { int pm, pn, e, tb; };
__device__ __forceinline__ bool static_next(int nM, int nN, int G, int c, int i, Unit& u) {
    const int nwg = nM * nN; const long L = (long)i * G + c; if (L >= nwg) return false;
    int wgid = (int)L; { const int q = nwg / NXCD, r = nwg % NXCD, xcd = wgid % NXCD, off = wgid / NXCD; wgid = (xcd < r ? xcd * (q + 1) : r * (q + 1) + (xcd - r) * q) + off; }
    const int nig = WGM * nN, gid = wgid / nig, fm = gid * WGM, gsz = (nM - fm) < WGM ? (nM - fm) : WGM;
    u.pm = fm + ((wgid % nig) % gsz); u.pn = (wgid % nig) / gsz; u.e = 0; u.tb = 0; return true;
}

template <class Prob, class Epi, bool ALIGN_EPI>
__device__ __forceinline__ void gemm_phase(LAS unsigned char* lds, const Prob& P, const Epi& E) {
    int tid_ = threadIdx.x; asm volatile("" : "+v"(tid_));
    const int tid = tid_, wid = __builtin_amdgcn_readfirstlane(tid >> 6), lane = tid & 63, wr = wid >> 2, wc = wid & 3, fr = lane & 15, fq = lane >> 4;
    constexpr int LDA = Prob::LDA, LDB = Prob::LDB;
    constexpr size_t HSTEPA = (size_t)HALF * LDA * 2, HSTEPB = (size_t)HALF * LDB * 2, KSTEP = BK * 2;
    int sR[2], sC[2]; unsigned voffA[2], voffB[2];
#pragma unroll
    for (int i = 0; i < 2; ++i) { stage_rc(tid * 16 + i * 8192, sR[i], sC[i]); const int Rb = Epi::PERM ? ((sR[i] & ~31) + perm32(sR[i] & 31)) : sR[i];
        voffA[i] = (unsigned)(sR[i] * LDA + sC[i]) * 2u; voffB[i] = (unsigned)(Rb * LDB + sC[i]) * 2u; }
    unsigned gc[2][2];
    LAS u32x4* gnl = (LAS u32x4*)(lds + STAGE_BYTES) + tid;
    const unsigned ldsw = (unsigned)wid * 1024u;
    const int aoff = lds_byte(wr * 64 + fr, fq * 8), boff = lds_byte(wc * 32 + fr, fq * 8);
#define PG_SA(b, h) (((b) * 2 + (h)) * HTB)
#define PG_SB(b, h) ((4 + (b) * 2 + (h)) * HTB)
#define PG_GLDS(bufoff, gptr, o0, o1) do { \
        __builtin_amdgcn_global_load_lds((const unsigned*)((const char*)(gptr) + (o0)), (LAS unsigned*)(lds + (bufoff) + ldsw), 16, 0, 0); \
        __builtin_amdgcn_global_load_lds((const unsigned*)((const char*)(gptr) + (o1)), (LAS unsigned*)(lds + (bufoff) + ldsw + 8192), 16, 0, 0); } while (0)
#define PG_STAGE_B(bufoff, gptr) PG_GLDS(bufoff, gptr, voffB[0], voffB[1])
#define PG_STAGE_A(bufoff, gptr, h, NX) do { if constexpr (Prob::GATHER) { PG_GLDS(bufoff, gptr, gc[h][0], gc[h][1]); } \
        else PG_GLDS(bufoff, (const char*)(gptr) + (h) * HSTEPA, voffA[0], voffA[1]); } while (0)
#define PG_LDA(dst, b, h) do { _Pragma("unroll") for (int m = 0; m < 4; ++m) _Pragma("unroll") for (int k = 0; k < 2; ++k) dst[m][k] = *(const LAS bf16x8*)(lds + PG_SA(b, h) + aoff + m * 2048 + k * 1024); } while (0)
#define PG_LDB(dst, b, h) do { _Pragma("unroll") for (int n = 0; n < 2; ++n) _Pragma("unroll") for (int k = 0; k < 2; ++k) dst[n][k] = *(const LAS bf16x8*)(lds + PG_SB(b, h) + boff + n * 2048 + k * 1024); } while (0)
#define PG_MMA(ai, bj, At, Bt) do { __builtin_amdgcn_s_setprio(1); _Pragma("unroll") for (int m = 0; m < 4; ++m) _Pragma("unroll") for (int n = 0; n < 2; ++n) _Pragma("unroll") for (int k = 0; k < 2; ++k) \
        { if constexpr (Prob::I8) acc[ai][bj][m][n] = __builtin_amdgcn_mfma_i32_16x16x64_i8(__builtin_bit_cast(i32x4, Bt[n][k]), __builtin_bit_cast(i32x4, At[m][k]), acc[ai][bj][m][n], 0, 0, 0); \
          else acc[ai][bj][m][n] = __builtin_amdgcn_mfma_f32_16x16x32_bf16(Bt[n][k], At[m][k], acc[ai][bj][m][n], 0, 0, 0); } __builtin_amdgcn_s_setprio(0); } while (0)
#define PG_WAIT_V(n) asm volatile("s_waitcnt vmcnt(" #n ")" ::: "memory")
#define PG_WAIT_L(n) asm volatile("s_waitcnt lgkmcnt(" #n ")" ::: "memory")
#define PG_BAR __builtin_amdgcn_s_barrier()
#define PG_SCHED __builtin_amdgcn_sched_barrier(0)
#define PG_GOFF(dst, u) do { if constexpr (Prob::GATHER) { int t_ = tid; asm volatile("" : "+v"(t_));   \
        _Pragma("unroll") for (int i = 0; i < 2; ++i) { int R_, C_; stage_rc(t_ * 16 + i * 8192, R_, C_); _Pragma("unroll") for (int h = 0; h < 2; ++h) \
        dst[h][i] = (unsigned)(P.tok(u, h * HALF + R_) * LDA + C_) * 2u; } } } while (0)
    Unit cur, nxt; int ui = 0;
    if (!P.next(0, cur)) return;
    typedef typename Prob::AccT AccT;
    AccT acc[2][2][4][2];
#pragma unroll
    for (int a = 0; a < 2; ++a)
#pragma unroll
        for (int b = 0; b < 2; ++b)
#pragma unroll
            for (int m = 0; m < 4; ++m)
#pragma unroll
                for (int n = 0; n < 2; ++n) acc[a][b][m][n] = (AccT){0, 0, 0, 0};
    bf16x8 At[4][2], B0[2][2], B1[2][2];
    PG_GOFF(gc, cur);
    {
        const char* cA0 = P.a_tile(cur, 0); const char* cB0 = P.b_tile(cur, 0); const char* cA1 = P.a_tile(cur, 1); const char* cB1 = P.b_tile(cur, 1);
        PG_STAGE_B(PG_SB(0, 0), cB0); PG_STAGE_B(PG_SB(0, 1), cB0 + HSTEPB); PG_STAGE_A(PG_SA(0, 0), cA0, 0, false); PG_STAGE_A(PG_SA(0, 1), cA0, 1, false);
        if (wr == 1) PG_BAR;
        PG_WAIT_V(2); PG_BAR;
        PG_STAGE_B(PG_SB(1, 0), cB1); PG_STAGE_A(PG_SA(1, 0), cA1, 0, false); PG_STAGE_B(PG_SB(1, 1), cB1 + HSTEPB);
        PG_WAIT_V(6); PG_BAR;
    }
    for (;;) {
        const bool has_next = P.next(ui + 1, nxt);
        if (!has_next) nxt = cur;
        if constexpr (Prob::GATHER) { if (has_next) { unsigned gn[2][2]; PG_GOFF(gn, nxt); *gnl = (u32x4){gn[0][0], gn[0][1], gn[1][0], gn[1][1]}; } }
        const int nt = P.nt(cur);
        for (int t = 0; t < nt; t += 2) {
            const bool last = (t == nt - 2);
            const char* a1 = P.a_tile(cur, t + 1);
            const char* a2 = last ? P.a_tile(nxt, 0) : P.a_tile(cur, t + 2); const char* b2 = last ? P.b_tile(nxt, 0) : P.b_tile(cur, t + 2);
            const char* a3 = last ? P.a_tile(nxt, 1) : P.a_tile(cur, t + 3); const char* b3 = last ? P.b_tile(nxt, 1) : P.b_tile(cur, t + 3);
            PG_LDB(B0, 0, 0); PG_LDB(B1, 0, 1); PG_SCHED; PG_LDA(At, 0, 0); PG_STAGE_A(PG_SA(1, 1), a1, 1, false);
            if constexpr (Prob::GATHER) { if (last && has_next) { const u32x4 g_ = *gnl; gc[0][0] = g_.x; gc[0][1] = g_.y; gc[1][0] = g_.z; gc[1][1] = g_.w; } }
            PG_WAIT_V(8); PG_WAIT_L(0); PG_BAR; PG_MMA(0, 0, At, B0); PG_MMA(0, 1, At, B1); PG_BAR; PG_SCHED;
            PG_LDA(At, 0, 1); PG_STAGE_B(PG_SB(0, 0), b2); PG_STAGE_B(PG_SB(0, 1), b2 + HSTEPB); PG_STAGE_A(PG_SA(0, 0), a2, 0, last);
            PG_WAIT_V(8); PG_WAIT_L(0); PG_BAR; PG_MMA(1, 0, At, B0); PG_MMA(1, 1, At, B1); PG_BAR; PG_SCHED;
            PG_LDB(B0, 1, 0); PG_LDB(B1, 1, 1); PG_SCHED; PG_LDA(At, 1, 0); PG_STAGE_A(PG_SA(0, 1), a2, 1, last);
            PG_WAIT_V(8); PG_WAIT_L(0); PG_BAR; PG_MMA(0, 0, At, B0); PG_MMA(0, 1, At, B1); PG_BAR; PG_SCHED;
            PG_LDA(At, 1, 1); PG_STAGE_B(PG_SB(1, 0), b3); PG_STAGE_B(PG_SB(1, 1), b3 + HSTEPB); PG_STAGE_A(PG_SA(1, 0), a3, 0, last);
            PG_WAIT_V(8); PG_WAIT_L(0); PG_BAR; PG_MMA(1, 0, At, B0); PG_MMA(1, 1, At, B1); PG_BAR; PG_SCHED;
            if constexpr (Prob::NSEG > 1) { const int sg = P.seg_end(t + 2); if (sg >= 0) E.mid(acc, cur, sg, wr, wc, fr, fq); }
        }
        if constexpr (ALIGN_EPI) { if (wr == 0) PG_BAR; }
        E(acc, cur, wr, wc, fr, fq);
        if (!has_next) break;
#pragma unroll
        for (int a = 0; a < 2; ++a)
#pragma unroll
            for (int b = 0; b < 2; ++b)
#pragma unroll
                for (int m = 0; m < 4; ++m)
#pragma unroll
                    for (int n = 0; n < 2; ++n) acc[a][b][m][n] = (AccT){0, 0, 0, 0};
        cur = nxt; ++ui;
        if constexpr (ALIGN_EPI) { if (wr == 1) PG_BAR; }
    }
    PG_WAIT_V(0);
    if constexpr (!ALIGN_EPI) { if (wr == 0) PG_BAR; }
    PG_BAR;
#undef PG_SA
#undef PG_SB
#undef PG_GLDS
#undef PG_STAGE_A
#undef PG_STAGE_B
#undef PG_LDA
#undef PG_LDB
#undef PG_MMA
#undef PG_WAIT_V
#undef PG_WAIT_L
#undef PG_BAR
#undef PG_SCHED
#undef PG_GOFF
}

struct ProbDense {
    static constexpr int LDA = 1024, LDB = 1024, NSEG = 1; static constexpr bool GATHER = false, I8 = false; typedef f32x4 AccT;
    const char* A; const char* Bt; int nN, G, c;
    __device__ __forceinline__ bool next(int i, Unit& u) const { return static_next(M / 256, nN, G, c, i, u); }
    __device__ __forceinline__ int nt(const Unit&) const { return 16; }
    __device__ __forceinline__ const char* a_tile(const Unit& u, int t) const { return A + (size_t)u.pm * (256 * LDA * 2) + t * 128; }
    __device__ __forceinline__ const char* b_tile(const Unit& u, int t) const { return Bt + (size_t)u.pn * (256 * LDB * 2) + t * 128; }
    __device__ __forceinline__ int tok(const Unit&, int) const { return 0; }
    __device__ __forceinline__ int seg_end(int) const { return -1; }
};
struct ProbDenseQ {
    static constexpr int LDA = 512, LDB = 512, NSEG = 1; static constexpr bool GATHER = false, I8 = true; typedef i32x4 AccT;
    const char* A; const char* Bt; int nN, G, c;
    __device__ __forceinline__ bool next(int i, Unit& u) const { return static_next(M / 256, nN, G, c, i, u); }
    __device__ __forceinline__ int nt(const Unit&) const { return 8; }
    __device__ __forceinline__ const char* a_tile(const Unit& u, int t) const { return A + (size_t)u.pm * (256 * LDA * 2) + t * 128; }
    __device__ __forceinline__ const char* b_tile(const Unit& u, int t) const { return Bt + (size_t)u.pn * (256 * LDB * 2) + t * 128; }
    __device__ __forceinline__ int tok(const Unit&, int) const { return 0; }
    __device__ __forceinline__ int seg_end(int) const { return -1; }
};
struct ProbP3 {
    static constexpr int LDA = LDOPS, LDB = 1024, NSEG = 3; static constexpr bool GATHER = false, I8 = false; typedef f32x4 AccT;
    const char* A; const char* Wa; const char* Wb; const char* Wc; int G, c;
    __device__ __forceinline__ bool next(int i, Unit& u) const { return static_next(M / 256, 4, G, c, i, u); }
    __device__ __forceinline__ int nt(const Unit&) const { return 36; }
    __device__ __forceinline__ const char* a_tile(const Unit& u, int t) const {
        const char* base = A + (size_t)u.pm * (256 * LDA * 2);
        return t < 16 ? base + t * 128 : (t < 32 ? base + OPS_SEG * 2 + (t - 16) * 128 : base + 2 * OPS_SEG * 2 + (256 * u.pn) * 2 + (t - 32) * 128); }
    __device__ __forceinline__ const char* b_tile(const Unit& u, int t) const {
        const size_t ro = (size_t)u.pn * (256 * LDB * 2);
        return t < 16 ? Wa + ro + t * 128 : (t < 32 ? Wb + ro + (t - 16) * 128 : Wc + ro + (256 * u.pn) * 2 + (t - 32) * 128); }
    __device__ __forceinline__ int tok(const Unit&, int) const { return 0; }
    __device__ __forceinline__ int seg_end(int t2) const { return t2 == 16 ? 0 : (t2 == 32 ? 1 : -1); }
};
template <int LDA_, int LDB_, int NT_, bool GATHER_, int REP = 1, bool I8_ = false> struct ProbMoe {
    static constexpr int LDA = LDA_, LDB = LDB_, NSEG = 1; static constexpr bool GATHER = GATHER_, I8 = I8_; typedef typename std::conditional<I8_, i32x4, f32x4>::type AccT;
    const char* A; const char* Bt; const int* etok; const volatile LAS int* pref; int G, c;
    __device__ __forceinline__ bool next(int i, Unit& u) const {
        const long L = (long)i * G + c; const int NT = pref[16]; if (L >= 4L * NT * REP) return false;
        const int rtg = (int)(L >> 2) % NT; u.pm = rtg; u.pn = (int)(L & 3); int e = 0;
#pragma unroll
        for (int j = 1; j < 16; ++j) e += (rtg >= pref[j]) ? 1 : 0;
        u.e = e; u.tb = e * M + (rtg - pref[e]) * 256; return true; }
    __device__ __forceinline__ int nt(const Unit&) const { return NT_; }
    __device__ __forceinline__ const char* a_tile(const Unit& u, int t) const { return GATHER ? A + t * 128 : A + (size_t)u.pm * (256 * LDA * 2) + t * 128; }
    __device__ __forceinline__ const char* b_tile(const Unit& u, int t) const { return Bt + ((size_t)u.e * 1024 + (size_t)u.pn * 256) * (LDB * 2) + t * 128; }
    __device__ __forceinline__ int tok(const Unit& u, int r) const { return etok[u.tb + r]; }
    __device__ __forceinline__ int seg_end(int) const { return -1; }
};

__device__ __forceinline__ void st_bf16x8(bf16_t* p, const f32x4 v0, const f32x4 v1) {
    u32x4 w; w.x = cvt_pk_bf16(v0[0], v0[1]); w.y = cvt_pk_bf16(v0[2], v0[3]); w.z = cvt_pk_bf16(v1[0], v1[1]); w.w = cvt_pk_bf16(v1[2], v1[3]);
    asm volatile("global_store_dwordx4 %0, %1, off sc1\n\ts_nop 1" :: "v"(p), "v"(w) : "memory"); }
__device__ __forceinline__ f32x4 cvt4(const i32x4 a) { return (f32x4){(float)a[0], (float)a[1], (float)a[2], (float)a[3]}; }
struct EpiG1aQ {
    static constexpr bool PERM = true; bf16_t* PA; const float* bias; const float* ws; const float* xs;
    __device__ __forceinline__ void operator()(const i32x4 (&acc)[2][2][4][2], const Unit& u, int wr, int wc, int fr, int fq) const {
        const int row0 = u.pm * BM + wr * 64 + fr, j0 = wc * 32 + 8 * fq; const float* bp = bias + u.pn * 256 + j0; const float* sp = ws + u.pn * 256 + j0;
        f32x4 bv[2][2], cs[2][2];
#pragma unroll
        for (int bj = 0; bj < 2; ++bj)
#pragma unroll
            for (int n = 0; n < 2; ++n) { bv[bj][n] = *(const f32x4*)(bp + bj * HALF + 4 * n); cs[bj][n] = *(const f32x4*)(sp + bj * HALF + 4 * n); }
        float rsv[2][4];
#pragma unroll
        for (int ai = 0; ai < 2; ++ai)
#pragma unroll
            for (int m = 0; m < 4; ++m) rsv[ai][m] = xs[row0 + ai * HALF + m * 16];
        if (u.pn < 16) {
            const bool glu = u.pn < 8; const int oc = (glu ? 128 * u.pn : 1024 + 128 * (u.pn - 8)) + j0;
#pragma unroll
            for (int ai = 0; ai < 2; ++ai)
#pragma unroll
                for (int m = 0; m < 4; ++m) { const int row = row0 + ai * HALF + m * 16; const float rs = rsv[ai][m]; bf16_t* rowp = PA + (size_t)row * LDPA + oc; f32x4 o[2];
#pragma unroll
                    for (int n = 0; n < 2; ++n) { const f32x4 v = cvt4(acc[ai][0][m][n]) * (cs[0][n] * rs) + bv[0][n], g = cvt4(acc[ai][1][m][n]) * (cs[1][n] * rs) + bv[1][n];
#pragma unroll
                        for (int e = 0; e < 4; ++e) o[n][e] = glu ? v[e] * sigmoidf_(g[e]) : v[e] * g[e]; }
                    st_bf16x8(rowp, o[0], o[1]); }
        } else {
            const int oc = (u.pn < 20 ? 2048 + 256 * (u.pn - 16) : 3072 + 256 * (u.pn - 20)) + j0;
#pragma unroll
            for (int ai = 0; ai < 2; ++ai)
#pragma unroll
                for (int m = 0; m < 4; ++m) { const int row = row0 + ai * HALF + m * 16; const float rs = rsv[ai][m]; bf16_t* rowp = PA + (size_t)row * LDPA + oc;
#pragma unroll
                    for (int bj = 0; bj < 2; ++bj) st_bf16x8(rowp + bj * HALF, cvt4(acc[ai][bj][m][0]) * (cs[bj][0] * rs) + bv[bj][0], cvt4(acc[ai][bj][m][1]) * (cs[bj][1] * rs) + bv[bj][1]); }
        }
    }
};
struct EpiG1bQ {
    static constexpr bool PERM = true; bf16_t* PA; const float* bias; const float* ws; const float* xs;
    __device__ __forceinline__ void operator()(const i32x4 (&acc)[2][2][4][2], const Unit& u, int wr, int wc, int fr, int fq) const {
        const int row0 = u.pm * BM + wr * 64 + fr, c0 = u.pn * 256 + wc * 32 + 8 * fq;
        f32x4 bv[2][2], cs[2][2];
#pragma unroll
        for (int bj = 0; bj < 2; ++bj)
#pragma unroll
            for (int n = 0; n < 2; ++n) { bv[bj][n] = *(const f32x4*)(bias + c0 + bj * HALF + 4 * n); cs[bj][n] = *(const f32x4*)(ws + c0 + bj * HALF + 4 * n); }
        float rsv[2][4];
#pragma unroll
        for (int ai = 0; ai < 2; ++ai)
#pragma unroll
            for (int m = 0; m < 4; ++m) rsv[ai][m] = xs[row0 + ai * HALF + m * 16];
#pragma unroll
        for (int ai = 0; ai < 2; ++ai)
#pragma unroll
            for (int m = 0; m < 4; ++m) { const int row = row0 + ai * HALF + m * 16; const float rs = rsv[ai][m]; bf16_t* rowp = PA + (size_t)row * LDPA + c0;
#pragma unroll
                for (int bj = 0; bj < 2; ++bj) { f32x4 o[2];
#pragma unroll
                    for (int n = 0; n < 2; ++n) { const f32x4 v = cvt4(acc[ai][bj][m][n]) * (cs[bj][n] * rs) + bv[bj][n];
#pragma unroll
                        for (int e = 0; e < 4; ++e) o[n][e] = gate_clamp(v[e]); }
                    st_bf16x8(rowp + bj * HALF, o[0], o[1]); } }
    }
};
struct EpiUpQ {
    static constexpr bool PERM = true; bf16_t* H; const float* ws; const float* xs; const int* etok;
    __device__ __forceinline__ void operator()(const i32x4 (&acc)[2][2][4][2], const Unit& u, int wr, int wc, int fr, int fq) const {
        const int rl0 = wr * 64 + fr, j0 = wc * 32 + 8 * fq, oc = 128 * u.pn + j0; const float* sp = ws + u.e * 1024 + u.pn * 256 + j0;
        f32x4 cs[2][2];
#pragma unroll
        for (int bj = 0; bj < 2; ++bj)
#pragma unroll
            for (int n = 0; n < 2; ++n) cs[bj][n] = *(const f32x4*)(sp + bj * HALF + 4 * n);
        int tk[2][4]; float rsv[2][4];
#pragma unroll
        for (int ai = 0; ai < 2; ++ai)
#pragma unroll
            for (int m = 0; m < 4; ++m) tk[ai][m] = etok[u.tb + rl0 + ai * HALF + m * 16];
#pragma unroll
        for (int ai = 0; ai < 2; ++ai)
#pragma unroll
            for (int m = 0; m < 4; ++m) rsv[ai][m] = xs[tk[ai][m]];
#pragma unroll
        for (int ai = 0; ai < 2; ++ai)
#pragma unroll
            for (int m = 0; m < 4; ++m) { const int rl = rl0 + ai * HALF + m * 16; const float rs = rsv[ai][m]; f32x4 o[2];
#pragma unroll
                for (int n = 0; n < 2; ++n) { const f32x4 g = cvt4(acc[ai][0][m][n]) * (cs[0][n] * rs), up = cvt4(acc[ai][1][m][n]) * (cs[1][n] * rs);
#pragma unroll
                    for (int e = 0; e < 4; ++e) o[n][e] = siluf_(g[e]) * up[e]; }
                st_bf16x8(H + (size_t)(u.pm * BM + rl) * DE + oc, o[0], o[1]); }
    }
};
struct EpiG1a {
    static constexpr bool PERM = true; bf16_t* PA; const float* bias;
    __device__ __forceinline__ void operator()(const f32x4 (&acc)[2][2][4][2], const Unit& u, int wr, int wc, int fr, int fq) const {
        const int row0 = u.pm * BM + wr * 64 + fr, j0 = wc * 32 + 8 * fq; const float* bp = bias + u.pn * 256 + j0;
        f32x4 bv[2][2];
#pragma unroll
        for (int bj = 0; bj < 2; ++bj)
#pragma unroll
            for (int n = 0; n < 2; ++n) bv[bj][n] = *(const f32x4*)(bp + bj * HALF + 4 * n);
        if (u.pn < 16) {
            const bool glu = u.pn < 8; const int oc = (glu ? 128 * u.pn : 1024 + 128 * (u.pn - 8)) + j0;
#pragma unroll
            for (int ai = 0; ai < 2; ++ai)
#pragma unroll
                for (int m = 0; m < 4; ++m) { bf16_t* rowp = PA + (size_t)(row0 + ai * HALF + m * 16) * LDPA + oc; f32x4 o[2];
#pragma unroll
                    for (int n = 0; n < 2; ++n) { const f32x4 v = acc[ai][0][m][n] + bv[0][n], g = acc[ai][1][m][n] + bv[1][n];
#pragma unroll
                        for (int e = 0; e < 4; ++e) o[n][e] = glu ? v[e] * sigmoidf_(g[e]) : v[e] * g[e]; }
                    st_bf16x8(rowp, o[0], o[1]); }
        } else {
            const int oc = (u.pn < 20 ? 2048 + 256 * (u.pn - 16) : 3072 + 256 * (u.pn - 20)) + j0;
#pragma unroll
            for (int ai = 0; ai < 2; ++ai)
#pragma unroll
                for (int m = 0; m < 4; ++m) { bf16_t* rowp = PA + (size_t)(row0 + ai * HALF + m * 16) * LDPA + oc;
#pragma unroll
                    for (int bj = 0; bj < 2; ++bj) st_bf16x8(rowp + bj * HALF, acc[ai][bj][m][0] + bv[bj][0], acc[ai][bj][m][1] + bv[bj][1]); }
        }
    }
};
struct EpiG1b {
    static constexpr bool PERM = true; bf16_t* PA; const float* bias;
    __device__ __forceinline__ void operator()(const f32x4 (&acc)[2][2][4][2], const Unit& u, int wr, int wc, int fr, int fq) const {
        const int row0 = u.pm * BM + wr * 64 + fr, c0 = u.pn * 256 + wc * 32 + 8 * fq;
        f32x4 bv[2][2];
#pragma unroll
        for (int bj = 0; bj < 2; ++bj)
#pragma unroll
            for (int n = 0; n < 2; ++n) bv[bj][n] = *(const f32x4*)(bias + c0 + bj * HALF + 4 * n);
#pragma unroll
        for (int ai = 0; ai < 2; ++ai)
#pragma unroll
            for (int m = 0; m < 4; ++m) { bf16_t* rowp = PA + (size_t)(row0 + ai * HALF + m * 16) * LDPA + c0;
#pragma unroll
                for (int bj = 0; bj < 2; ++bj) { f32x4 o[2];
#pragma unroll
                    for (int n = 0; n < 2; ++n) { const f32x4 v = acc[ai][bj][m][n] + bv[bj][n];
#pragma unroll
                        for (int e = 0; e < 4; ++e) o[n][e] = gate_clamp(v[e]); }
                    st_bf16x8(rowp + bj * HALF, o[0], o[1]); } }
    }
};
struct EpiP3 {
    static constexpr bool PERM = true; const bf16_t* GT; bf16_t* O;
    __device__ __forceinline__ void mid(f32x4 (&acc)[2][2][4][2], const Unit& u, int seg, int wr, int wc, int fr, int fq) const {
        int row0 = u.pm * BM + wr * 64 + fr; asm volatile("" : "+v"(row0)); const int c0 = u.pn * 256 + wc * 32 + 8 * fq;
#pragma unroll
        for (int ai = 0; ai < 2; ++ai) { u32x4 nu[4][2], de[4][2];
#pragma unroll
            for (int m = 0; m < 4; ++m) { const bf16_t* gp = GT + (size_t)(row0 + ai * HALF + m * 16) * LDPA + seg * 1024 + c0;
#pragma unroll
                for (int bj = 0; bj < 2; ++bj) { nu[m][bj] = *(const u32x4*)(gp + bj * HALF); de[m][bj] = *(const u32x4*)(gp + 1024 + bj * HALF); } }
#pragma unroll
            for (int m = 0; m < 4; ++m)
#pragma unroll
                for (int bj = 0; bj < 2; ++bj) { float fn[8], fd[8]; unpack8(nu[m][bj], fn); unpack8(de[m][bj], fd);
#pragma unroll
                    for (int e = 0; e < 4; ++e) { acc[ai][bj][m][0][e] *= fn[e] * __builtin_amdgcn_rcpf(fd[e]); acc[ai][bj][m][1][e] *= fn[4 + e] * __builtin_amdgcn_rcpf(fd[4 + e]); } }
            asm volatile("" ::: "memory"); }
    }
    __device__ __forceinline__ void operator()(const f32x4 (&acc)[2][2][4][2], const Unit& u, int wr, int wc, int fr, int fq) const {
        const int row0 = u.pm * BM + wr * 64 + fr, c0 = u.pn * 256 + wc * 32 + 8 * fq;
#pragma unroll
        for (int ai = 0; ai < 2; ++ai) { u32x4 g2[4][2];
#pragma unroll
            for (int m = 0; m < 4; ++m)
#pragma unroll
                for (int bj = 0; bj < 2; ++bj) g2[m][bj] = *(const u32x4*)(GT + (size_t)(row0 + ai * HALF + m * 16) * LDPA + 2048 + c0 + bj * HALF);
#pragma unroll
            for (int m = 0; m < 4; ++m) { const size_t r = (size_t)(row0 + ai * HALF + m * 16);
#pragma unroll
                for (int bj = 0; bj < 2; ++bj) { float fg[8]; unpack8(g2[m][bj], fg); f32x4 o0, o1;
#pragma unroll
                    for (int e = 0; e < 4; ++e) { o0[e] = acc[ai][bj][m][0][e] * fg[e]; o1[e] = acc[ai][bj][m][1][e] * fg[4 + e]; }
                    st_bf16x8(O + r * 1024 + c0 + bj * HALF, o0, o1); } }
            asm volatile("" ::: "memory"); }
    }
};
struct EpiP4 {
    static constexpr bool PERM = false; const float* res; float* out; const float* bias;
    __device__ __forceinline__ void operator()(const f32x4 (&acc)[2][2][4][2], const Unit& u, int wr, int wc, int fr, int fq) const {
        const int row0 = u.pm * BM + wr * 64 + fr, col0 = u.pn * BM + wc * 32 + 4 * fq;
        f32x4 bv[2][2];
#pragma unroll
        for (int bj = 0; bj < 2; ++bj)
#pragma unroll
            for (int n = 0; n < 2; ++n) bv[bj][n] = *(const f32x4*)(bias + col0 + bj * HALF + n * 16);
#pragma unroll
        for (int ai = 0; ai < 2; ++ai) { f32x4 rs[4][2][2];
#pragma unroll
            for (int m = 0; m < 4; ++m) { const size_t off = (size_t)(row0 + ai * HALF + m * 16) * 1024 + col0;
#pragma unroll
                for (int bj = 0; bj < 2; ++bj)
#pragma unroll
                    for (int n = 0; n < 2; ++n) rs[m][bj][n] = *(const f32x4*)(res + off + bj * HALF + n * 16); }
#pragma unroll
            for (int m = 0; m < 4; ++m) { const size_t off = (size_t)(row0 + ai * HALF + m * 16) * 1024 + col0;
#pragma unroll
                for (int bj = 0; bj < 2; ++bj)
#pragma unroll
                    for (int n = 0; n < 2; ++n) *(f32x4*)(out + off + bj * HALF + n * 16) = rs[m][bj][n] * ALPHA + acc[ai][bj][m][n] + bv[bj][n]; }
            asm volatile("" ::: "memory"); }
    }
};
struct EpiUp {
    static constexpr bool PERM = true; bf16_t* H;
    __device__ __forceinline__ void operator()(const f32x4 (&acc)[2][2][4][2], const Unit& u, int wr, int wc, int fr, int fq) const {
        const int row0 = u.pm * BM + wr * 64 + fr, oc = 128 * u.pn + wc * 32 + 8 * fq;
#pragma unroll
        for (int ai = 0; ai < 2; ++ai)
#pragma unroll
            for (int m = 0; m < 4; ++m) { f32x4 o[2];
#pragma unroll
                for (int n = 0; n < 2; ++n)
#pragma unroll
                    for (int e = 0; e < 4; ++e) o[n][e] = siluf_(acc[ai][0][m][n][e]) * acc[ai][1][m][n][e];
                st_bf16x8(H + (size_t)(row0 + ai * HALF + m * 16) * DE + oc, o[0], o[1]); }
    }
};
struct EpiDown {
    static constexpr bool PERM = true; bf16_t* YS;
    __device__ __forceinline__ void operator()(const f32x4 (&acc)[2][2][4][2], const Unit& u, int wr, int wc, int fr, int fq) const {
        const int row0 = u.pm * BM + wr * 64 + fr, c0 = u.pn * 256 + wc * 32 + 8 * fq;
#pragma unroll
        for (int ai = 0; ai < 2; ++ai)
#pragma unroll
            for (int m = 0; m < 4; ++m) { bf16_t* rowp = YS + (size_t)(row0 + ai * HALF + m * 16) * 1024 + c0;
#pragma unroll
                for (int bj = 0; bj < 2; ++bj) st_bf16x8(rowp + bj * HALF, acc[ai][bj][m][0], acc[ai][bj][m][1]); }
    }
};
}

__device__ __forceinline__ void tr_item(const float* src, int ld, int k0, int n0, bf16_t* dst, int ldd, int drow0, int dcol0, const float* scale, LAS float* scr, int lane) {
#pragma unroll 8
    for (int i = 0; i < 32; ++i) { const int kk = 2 * i + (lane >> 5); scr[kk * 33 + (lane & 31)] = src[(size_t)(k0 + kk) * ld + n0 + (lane & 31)]; }
    LDS_WAIT(); asm volatile("" ::: "memory");
    const int c = lane & 7;
#pragma unroll
    for (int j = 0; j < 4; ++j) { const int n = (lane >> 3) + 8 * j; const LAS float* s = scr + (8 * c) * 33 + n; const float sc = scale ? scale[drow0 + n] : 1.0f;
        u32x4 o; o.x = pk2(s[0 * 33] * sc, s[1 * 33] * sc); o.y = pk2(s[2 * 33] * sc, s[3 * 33] * sc); o.z = pk2(s[4 * 33] * sc, s[5 * 33] * sc); o.w = pk2(s[6 * 33] * sc, s[7 * 33] * sc);
        *(GAS u32x4*)(dst + (size_t)(drow0 + n) * ldd + dcol0 + k0 + 8 * c) = o; }
    LDS_WAIT(); asm volatile("" ::: "memory");
}
__device__ __forceinline__ float wave_max(float v) {
    v = fmaxf(v, dppf<DPP_XOR1>(v)); v = fmaxf(v, dppf<DPP_XOR2>(v)); v = fmaxf(v, dppf<DPP_XOR7>(v)); v = fmaxf(v, dppf<DPP_XOR8>(v));
    auto s = __builtin_amdgcn_permlane16_swap(__float_as_uint(v), __float_as_uint(v), false, false); v = fmaxf(__uint_as_float(s[0]), __uint_as_float(s[1]));
    auto t = __builtin_amdgcn_permlane32_swap(__float_as_uint(v), __float_as_uint(v), false, false); return fmaxf(__uint_as_float(t[0]), __uint_as_float(t[1]));
}
__device__ __forceinline__ unsigned q8pack(float a, float b, float c, float d) {
    const int qa = (int)__builtin_rintf(a), qb = (int)__builtin_rintf(b), qc = (int)__builtin_rintf(c), qd = (int)__builtin_rintf(d);
    return (unsigned)(qa & 0xff) | ((unsigned)(qb & 0xff) << 8) | ((unsigned)(qc & 0xff) << 16) | ((unsigned)qd << 24);
}
__device__ __forceinline__ void store_q8_row(q8_t* qrow, float* xs, const f32x4 (&v)[4], int lane) {
    float am = 0.f;
#pragma unroll
    for (int j = 0; j < 4; ++j) am = fmaxf(am, fmaxf(fmaxf(fabsf(v[j][0]), fabsf(v[j][1])), fmaxf(fabsf(v[j][2]), fabsf(v[j][3]))));
    am = wave_max(am);
    const float inv = am > 0.f ? 127.0f / am : 0.f;
#pragma unroll
    for (int j = 0; j < 4; ++j) *(unsigned*)(qrow + 256 * j + 4 * lane) = q8pack(v[j][0] * inv, v[j][1] * inv, v[j][2] * inv, v[j][3] * inv);
    if (lane == 0) *xs = am > 0.f ? am * (1.0f / 127.0f) : 1.0f;
}
struct Q8Item { const float* src; int ld, n0; q8_t* dst; int drow0; float* wscale; };
__device__ __forceinline__ void q8_load(const Q8Item& I, int tid, f32x4 (&v)[16]) {
    const float* sp = I.src + (size_t)(4 * (tid >> 3)) * I.ld + I.n0 + 4 * (tid & 7);
#pragma unroll
    for (int p = 0; p < 4; ++p)
#pragma unroll
        for (int r = 0; r < 4; ++r) v[4 * p + r] = *(const f32x4*)(sp + (size_t)(256 * p + r) * I.ld);
}
constexpr int Q8_STRIDE = 1040;
__device__ __forceinline__ void q8_quant(Frame& F, const Q8Item& I, const f32x4 (&v)[16]) {
    LAS float* red = (LAS float*)F.lds;
    LAS unsigned char* qT = F.lds + 1024;
    const int tid = F.tid, b = tid & 7;
    f32x4 am = (f32x4){0.f, 0.f, 0.f, 0.f};
#pragma unroll
    for (int i = 0; i < 16; ++i)
#pragma unroll
        for (int c = 0; c < 4; ++c) am[c] = fmaxf(am[c], fabsf(v[i][c]));
#pragma unroll
    for (int c = 0; c < 4; ++c) { float x = am[c]; x = fmaxf(x, dppf<DPP_XOR8>(x));
        auto s1 = __builtin_amdgcn_permlane16_swap(__float_as_uint(x), __float_as_uint(x), false, false); x = fmaxf(__uint_as_float(s1[0]), __uint_as_float(s1[1]));
        auto s2 = __builtin_amdgcn_permlane32_swap(__float_as_uint(x), __float_as_uint(x), false, false); am[c] = fmaxf(__uint_as_float(s2[0]), __uint_as_float(s2[1])); }
    if (F.lane < 8) *(LAS f32x4*)(red + F.wave * 32 + 4 * b) = am;
    LDS_WAIT(); __syncthreads();
    f32x4 inv;
#pragma unroll
    for (int w = 0; w < 8; ++w) { const f32x4 o = *(const LAS f32x4*)(red + w * 32 + 4 * b);
#pragma unroll
        for (int c = 0; c < 4; ++c) am[c] = fmaxf(am[c], o[c]); }
#pragma unroll
    for (int c = 0; c < 4; ++c) inv[c] = am[c] > 0.f ? 127.0f / am[c] : 0.f;
    if (tid < 8) { f32x4 sc;
#pragma unroll
        for (int c = 0; c < 4; ++c) sc[c] = am[c] > 0.f ? am[c] * (1.0f / 127.0f) : 1.0f;
        *(f32x4*)(I.wscale + I.drow0 + 4 * b) = sc; }
#pragma unroll
    for (int p = 0; p < 4; ++p)
#pragma unroll
        for (int c = 0; c < 4; ++c)
            *(LAS unsigned*)(qT + (4 * b + c) * Q8_STRIDE + 4 * ((tid >> 3) + 64 * p)) = q8pack(v[4 * p][c] * inv[c], v[4 * p + 1][c] * inv[c], v[4 * p + 2][c] * inv[c], v[4 * p + 3][c] * inv[c]);
    LDS_WAIT(); __syncthreads();
}
__device__ __forceinline__ void q8_store(Frame& F, const Q8Item& I) {
    const LAS unsigned char* qT = F.lds + 1024;
#pragma unroll
    for (int j = 0; j < 4; ++j) { const int idx = F.tid + 512 * j, n = idx >> 6, ch = idx & 63;
        *(GAS u32x4*)(I.dst + (size_t)(I.drow0 + n) * 1024 + 16 * ch) = *(const LAS u32x4*)(qT + n * Q8_STRIDE + 16 * ch); }
    LDS_WAIT(); __syncthreads();
}
__device__ __forceinline__ void phase_convert(Frame& F, int l) {
    unsigned char* wb = F.ws() + WS_WB;
    { const float* w_in = F.in(IN_WIN) + (size_t)l * DM * INC; float* ws1 = (float*)(wb + WB_WS1); float* wsup = (float*)(wb + WB_WSUP);
      const float* wg = F.in(IN_WG) + (size_t)l * NEXP * DM * DE; const float* wu = F.in(IN_WU) + (size_t)l * NEXP * DM * DE;
#define Q8_ITEM(I, it) do { if ((it) < 192) I = Q8Item{w_in, INC, src1a(32 * (it)), (q8_t*)(wb + WB_1A), 32 * (it), ws1}; \
          else if ((it) < 288) I = Q8Item{w_in, INC, 6144 + 32 * ((it) - 192), (q8_t*)(wb + WB_1B), 32 * ((it) - 192), ws1 + 6144}; \
          else { const int r_ = (it) - 288, e_ = r_ >> 5, nb_ = r_ & 31, uq_ = nb_ >> 3, rb_ = nb_ & 7; \
              I = Q8Item{(rb_ < 4 ? wg : wu) + (size_t)e_ * DM * DE, DE, 128 * uq_ + 32 * (rb_ & 3), (q8_t*)(wb + WB_UP) + (size_t)e_ * 1024 * 1024, 32 * nb_, wsup + e_ * 1024}; } } while (0)
      constexpr int NQ8 = 192 + 96 + 512;
      f32x4 v[16]; Q8Item cur, nxt; int it = F.bid;
      if (it < NQ8) { Q8_ITEM(cur, it); q8_load(cur, F.tid, v); }
      for (; it < NQ8; it += F.G) {
          q8_quant(F, cur, v);
          const bool more = it + F.G < NQ8;
          if (more) { Q8_ITEM(nxt, it + F.G); q8_load(nxt, F.tid, v); }
          q8_store(F, cur);
          if (more) cur = nxt;
      }
#undef Q8_ITEM
    }
    LAS float* scr = (LAS float*)(F.lds + F.wave * 16384);
    const int gw = F.bid * 8 + F.wave, NGW = F.G * 8;
    constexpr int I_SQ = 32 * 16, I_C = 4 * 32, I_DN = 16 * 256;
    constexpr int NITEMS = 3 * I_SQ + I_C + I_DN;
    for (int it = gw; it < NITEMS; it += NGW) {
        int r = it;
        if (r < 3 * I_SQ) { const int which = r / I_SQ, q = r % I_SQ, nb = q >> 4, kb = q & 15;
            const float* src = (which == 0 ? F.in(IN_WA) : (which == 1 ? F.in(IN_WB) : F.in(IN_WO))) + (size_t)l * DM * DM;
            bf16_t* dst = (bf16_t*)(wb + (which == 0 ? WB_WA : (which == 1 ? WB_WBB : WB_WO)));
            tr_item(src, DM, 64 * kb, 32 * nb, dst, 1024, 32 * nb, 0, nullptr, scr, F.lane); continue; } r -= 3 * I_SQ;
        if (r < I_C) { const int g = r >> 5, q = r & 31, nb = q >> 2, kb = q & 3;
            tr_item(F.in(IN_WC) + ((size_t)l * 4 + g) * 65536, 256, 64 * kb, 32 * nb, (bf16_t*)(wb + WB_WC), 1024, 256 * g + 32 * nb, 256 * g, F.in(IN_CS) + (size_t)l * DM, scr, F.lane); continue; } r -= I_C;
        { const int e = r >> 8, q = r & 255, nb = q >> 3, kb = q & 7;
            tr_item(F.in(IN_WD) + ((size_t)l * NEXP + e) * DE * DM, DM, 64 * kb, 32 * nb, (bf16_t*)(wb + WB_DN) + (size_t)e * 1024 * 512, 512, 32 * nb, 0, nullptr, scr, F.lane); }
    }
    float* bias = (float*)(wb + WB_BIAS); const float* b_in = F.in(IN_BIN) + (size_t)l * INC;
    for (int i = F.bid * 512 + F.tid; i < INC; i += F.G * 512) bias[i] = b_in[i < 6144 ? src1a(i) : i];
    if (l == 0) {
        q8_t* xq = (q8_t*)(F.ws() + WS_XB); float* xs = (float*)(F.ws() + WS_XS);
        for (int row = gw; row < M; row += NGW) { const float* xr = F.in(IN_X) + (size_t)row * DM + 4 * F.lane; f32x4 v[4];
#pragma unroll
            for (int j = 0; j < 4; ++j) v[j] = *(const f32x4*)(xr + 256 * j);
            store_q8_row(xq + (size_t)row * DM, xs + row, v, F.lane); }
    }
}

constexpr int P2_IN_BYTES = 46 * 2048, P2_OUT_OFF = P2_IN_BYTES, P2_TILES = M / 16;
__device__ __forceinline__ void p2_stage(Frame& F, const bf16_t* PA, const unsigned char* zero, int tt) {
    const int grow0 = tt * 16, t0 = grow0 & (SEQ - 1);
#pragma unroll
    for (int i = 0; i < 12; ++i) { const int p = F.wave + 8 * i; if (p < 92) { const int r = p >> 1, half = p & 1;
        const unsigned char* src = (t0 - 30 + r >= 0) ? (const unsigned char*)(PA + (size_t)(grow0 - 30 + r) * LDPA) + half * 1024 : zero;
        __builtin_amdgcn_global_load_lds((const unsigned*)(src + F.lane * 16), (LAS unsigned*)(F.lds + p * 1024), 16, 0, 0); } }
}
__device__ __forceinline__ void phase_p2(Frame& F, int l) {
    const bf16_t* PA = (const bf16_t*)(F.ws() + WS_PA); bf16_t* OPS = (bf16_t*)(F.ws() + WS_OPS);
    const unsigned char* zero = F.ws() + WS_ZERO;
    const int tid = F.tid, lane = F.lane, wave = F.wave;
    LAS unsigned char* lds = F.lds;
    const int pc = tid & 127, rg = tid >> 7;
    const int pw = 2 << (pc >> 5);
    const int nrep = (((DUP_MASK) >> PH_P2) & 1) + 1;
    const int tpb = P2_TILES / F.G; const bool contig = tpb * F.G == P2_TILES;
#define P2_TILE(x) (contig ? ((x) % F.G) * tpb + ((x) / F.G) % tpb : ((x) & (P2_TILES - 1)))
    int tt_ = F.bid;
    if (tt_ < P2_TILES * nrep) p2_stage(F, PA, zero, P2_TILE(tt_));
    for (; tt_ < P2_TILES * nrep; tt_ += F.G) { const int tt = P2_TILE(tt_);
        const int grow0 = tt * 16, t0 = grow0 & (SEQ - 1);
        {   const int r0 = 4 * rg, tb = t0 + r0; const bf16_t* prow = PA + (size_t)(grow0 + r0) * LDPA + 8 * pc;
            u32x4 cu[6], cg[4], cc[19];
#pragma unroll
            for (int k = 0; k < 6; ++k) { cu[k] = (u32x4){0u, 0u, 0u, 0u}; if (tb - 2 + k >= 0) cu[k] = *(const u32x4*)(prow + 1024 + (ptrdiff_t)(k - 2) * LDPA); }
#pragma unroll
            for (int k = 0; k < 4; ++k) cg[k] = *(const u32x4*)(prow + 3072 + (size_t)k * LDPA);
#pragma unroll
            for (int k = 0; k < 19; ++k) { cc[k] = (u32x4){0u, 0u, 0u, 0u}; if (k >= 16 - pw && tb - 15 + k >= 0) cc[k] = *(const u32x4*)(prow + 2048 + (ptrdiff_t)(k - 15) * LDPA); }
            float wb3[3][8];
#pragma unroll
            for (int k = 0; k < 3; ++k) { const f32x4 a = *(const f32x4*)(F.in(IN_CBW) + ((size_t)l * 3 + k) * DM + 8 * pc), b = *(const f32x4*)(F.in(IN_CBW) + ((size_t)l * 3 + k) * DM + 8 * pc + 4);
#pragma unroll
                for (int e = 0; e < 4; ++e) { wb3[k][e] = a[e]; wb3[k][4 + e] = b[e]; } }
#pragma unroll
            for (int i = 0; i < 4; ++i) { float u0[8], u1[8], u2[8], gb[8]; unpack8(cu[i], u0); unpack8(cu[i + 1], u1); unpack8(cu[i + 2], u2); unpack8(cg[i], gb); float o[8];
#pragma unroll
                for (int e = 0; e < 8; ++e) o[e] = gb[e] * (wb3[0][e] * u0[e] + wb3[1][e] * u1[e] + wb3[2][e] * u2[e]);
                u32x4 wv; wv.x = pk2(o[0], o[1]); wv.y = pk2(o[2], o[3]); wv.z = pk2(o[4], o[5]); wv.w = pk2(o[6], o[7]);
                *(u32x4*)(OPS + (size_t)(grow0 + r0 + i) * LDOPS + OPS_SEG + 8 * pc) = wv; }
#pragma unroll
            for (int i = 0; i < 4; ++i) { float s[8], self[8], f[8]; unpack8(cc[15 + i], self);
#pragma unroll
                for (int e = 0; e < 8; ++e) s[e] = self[e];
#pragma unroll
                for (int j = 1; j < 16; ++j) { if (j < pw) { unpack8(cc[15 + i - j], f);
#pragma unroll
                    for (int e = 0; e < 8; ++e) s[e] += f[e]; } }
                const int t = tb + i; const float inv = 1.0f / (float)(t + 1 < pw ? t + 1 : pw);
                u32x4 wv; wv.x = pk2(s[0] * inv - self[0], s[1] * inv - self[1]); wv.y = pk2(s[2] * inv - self[2], s[3] * inv - self[3]);
                wv.z = pk2(s[4] * inv - self[4], s[5] * inv - self[5]); wv.w = pk2(s[6] * inv - self[6], s[7] * inv - self[7]);
                *(u32x4*)(OPS + (size_t)(grow0 + r0 + i) * LDOPS + 2 * OPS_SEG + 8 * pc) = wv; }
        }
        f32x2 w[31]; f32x2 cb;
        { const float* cw = F.in(IN_CAW) + (size_t)l * 31 * DM + 2 * tid; asm volatile("" : "+v"(cw));
#pragma unroll
          for (int k = 0; k < 31; ++k) w[k] = *(const f32x2*)(cw + (size_t)k * DM);
          cb = *(const f32x2*)(F.in(IN_CAB) + (size_t)l * DM + 2 * tid); }
        f32x4 lg[4], lb[4];
#pragma unroll
        for (int q = 0; q < 4; ++q) { lg[q] = *(const f32x4*)(F.in(IN_LAG) + (size_t)l * DM + 256 * q + 4 * lane); lb[q] = *(const f32x4*)(F.in(IN_LAB) + (size_t)l * DM + 256 * q + 4 * lane); }
        VM_WAIT(); __syncthreads();
        f32x2 v[46];
#pragma unroll
        for (int r = 0; r < 46; ++r) { const unsigned bits = *(const LAS unsigned*)(lds + r * 2048 + tid * 4); v[r].x = __uint_as_float(bits << 16); v[r].y = __uint_as_float(bits & 0xffff0000u); }
        LDS_WAIT(); __syncthreads();
        if (tt_ + F.G < P2_TILES * nrep) p2_stage(F, PA, zero, P2_TILE(tt_ + F.G));
#pragma unroll
        for (int o = 0; o < 16; ++o) { f32x2 s = cb;
#pragma unroll
            for (int k = 0; k < 31; ++k) s += w[k] * v[o + k];
            *(LAS f32x2*)(lds + P2_OUT_OFF + o * 4096 + tid * 8) = s; }
        LDS_WAIT(); __builtin_amdgcn_s_barrier(); asm volatile("" ::: "memory");
#pragma unroll
        for (int rr = 0; rr < 2; ++rr) { const int r = wave * 2 + rr; f32x4 x[4]; float s = 0.f;
#pragma unroll
            for (int q = 0; q < 4; ++q) { x[q] = *(const LAS f32x4*)(lds + P2_OUT_OFF + r * 4096 + q * 1024 + lane * 16); s += (x[q][0] + x[q][1]) + (x[q][2] + x[q][3]); }
            const float mean = wave_sum(s) * (1.f / DM); float s2 = 0.f;
#pragma unroll
            for (int q = 0; q < 4; ++q) { x[q] = x[q] - mean; s2 += (x[q][0] * x[q][0] + x[q][1] * x[q][1]) + (x[q][2] * x[q][2] + x[q][3] * x[q][3]); }
            const float rstd = 1.f / sqrtf(wave_sum(s2) * (1.f / DM) + LN_EPS);
            bf16_t* orow = OPS + (size_t)(grow0 + r) * LDOPS;
#pragma unroll
            for (int q = 0; q < 4; ++q) { f32x4 y = x[q] * rstd * lg[q] + lb[q]; u32x2 o; o.x = pk2(siluf_(y[0]), siluf_(y[1])); o.y = pk2(siluf_(y[2]), siluf_(y[3]));
                *(u32x2*)(orow + 256 * q + 4 * lane) = o; } }
    }
    VM_WAIT(); __syncthreads();
}

__device__ __forceinline__ void phase_ln1r(Frame& F, int l, bool dry) {
    LAS float* wr_t = (LAS float*)F.lds;
    LAS int* rinfo = (LAS int*)(F.lds + 65536);
    const int tid = F.tid, lane = F.lane, wave = F.wave;
    { const float* wrg = F.in(IN_WR);
      for (int i = tid; i < DM * 16 / 4; i += 512) { const f32x4 v = *(const f32x4*)(wrg + 4 * i); const int c = i >> 2, e0 = (i & 3) * 4;
#pragma unroll
          for (int e = 0; e < 4; ++e) wr_t[(e0 + e) * DM + c] = v[e]; } }
    f32x4 g[4], b[4];
#pragma unroll
    for (int j = 0; j < 4; ++j) { g[j] = *(const f32x4*)(F.in(IN_L1G) + (size_t)l * DM + 256 * j + 4 * lane); b[j] = *(const f32x4*)(F.in(IN_L1B) + (size_t)l * DM + 256 * j + 4 * lane); }
    float br[16];
#pragma unroll
    for (int e = 0; e < 16; ++e) br[e] = F.in(IN_BR)[e];
    __syncthreads();
    q8_t* XQ = (q8_t*)(F.ws() + (dry ? WS_OPS + 64 * MiB : WS_XB)); float* XS = (float*)(F.ws() + (dry ? WS_OPS + 80 * MiB : WS_XS)); float* xo = dry ? (float*)(F.ws() + WS_OPS) : F.out();
    int* etok = (int*)(F.ws() + WS_ETOK); u32x4* tokinfo = (u32x4*)(F.ws() + WS_TOKINFO);
    for (int blk = F.bid; blk < M / 64; blk += F.G) {
        const float* xin = F.out() + ((size_t)blk * 64 + wave * 8) * DM + 4 * lane;
        f32x4 vn[4];
#pragma unroll
        for (int j = 0; j < 4; ++j) vn[j] = *(const f32x4*)(xin + 256 * j);
#pragma unroll 1
        for (int rr = 0; rr < 8; ++rr) { const int rl = wave * 8 + rr; const size_t row = (size_t)blk * 64 + rl;
            f32x4 v[4]; float s = 0.f;
#pragma unroll
            for (int j = 0; j < 4; ++j) { v[j] = vn[j]; s += (v[j][0] + v[j][1]) + (v[j][2] + v[j][3]); }
            { const int rn = rr < 7 ? rr + 1 : 7;
#pragma unroll
              for (int j = 0; j < 4; ++j) vn[j] = *(const f32x4*)(xin + (size_t)rn * DM + 256 * j); }
            const float mean = wave_sum(s) * (1.f / DM); float s2 = 0.f;
#pragma unroll
            for (int j = 0; j < 4; ++j) { v[j] = v[j] - mean; s2 += (v[j][0] * v[j][0] + v[j][1] * v[j][1]) + (v[j][2] * v[j][2] + v[j][3] * v[j][3]); }
            const float rstd = 1.f / sqrtf(wave_sum(s2) * (1.f / DM) + LN_EPS);
#pragma unroll
            for (int j = 0; j < 4; ++j) { v[j] = v[j] * rstd * g[j] + b[j]; *(f32x4*)(xo + row * DM + 256 * j + 4 * lane) = v[j]; }
            store_q8_row(XQ + row * DM, XS + row, v, lane);
            float a[16];
            const LAS float* wrl = wr_t + 4 * lane; asm volatile("" : "+v"(wrl));
#pragma unroll
            for (int e = 0; e < 16; ++e) { float a0 = 0.f;
#pragma unroll
                for (int j = 0; j < 4; ++j) { const f32x4 wv = *(const LAS f32x4*)(wrl + e * DM + 256 * j); a0 += (v[j][0] * wv[0] + v[j][1] * wv[1]) + (v[j][2] * wv[2] + v[j][3] * wv[3]); }
                a[e] = a0; }
            {
                float t8[8], t4[4], t2[2], t1;
                const bool h0 = (lane & 1) != 0, h1 = (lane & 2) != 0;
#pragma unroll
                for (int i = 0; i < 8; ++i) { auto r = __builtin_amdgcn_permlane32_swap(__float_as_uint(a[i]), __float_as_uint(a[8 + i]), false, false); t8[i] = __uint_as_float(r[0]) + __uint_as_float(r[1]); }
#pragma unroll
                for (int i = 0; i < 4; ++i) { auto r = __builtin_amdgcn_permlane16_swap(__float_as_uint(t8[i]), __float_as_uint(t8[4 + i]), false, false); t4[i] = __uint_as_float(r[0]) + __uint_as_float(r[1]); }
#pragma unroll
                for (int i = 0; i < 2; ++i) t2[i] = (h0 ? t4[2 + i] : t4[i]) + dppf<DPP_XOR1>(h0 ? t4[i] : t4[2 + i]);
                t1 = (h1 ? t2[1] : t2[0]) + dppf<DPP_XOR2>(h1 ? t2[0] : t2[1]);
                t1 += dppf<DPP_ROR4>(t1); t1 += dppf<DPP_XOR8>(t1);
                float lgt[16];
#pragma unroll
                for (int e = 0; e < 16; ++e) lgt[e] = __uint_as_float((unsigned)__builtin_amdgcn_readlane((int)__float_as_uint(t1), 32 * (e >> 3) + 16 * ((e >> 2) & 1) + ((e >> 1) & 1) + 2 * (e & 1))) + br[e];
                const Route rt = route16(lgt);
                if (lane == 0) { rinfo[rl * 4 + 0] = rt.e1; rinfo[rl * 4 + 1] = rt.e2; rinfo[rl * 4 + 2] = (int)__float_as_uint(rt.p1); } }
        }
        __syncthreads();
        if (wave == 0 && !dry) {
            const int e1 = rinfo[lane * 4 + 0], e2 = rinfo[lane * 4 + 1]; const unsigned p1b = (unsigned)rinfo[lane * 4 + 2];
            const unsigned long long ltm = (1ull << lane) - 1ull;
            int mycnt = 0, r1 = 0, r2 = 0;
#pragma unroll
            for (int e = 0; e < 16; ++e) { const unsigned long long m1 = __ballot(e1 == e), m2 = __ballot(e2 == e); const int c1 = __popcll(m1), c2 = __popcll(m2);
                if (lane == e) mycnt = c1 + c2;
                if (e1 == e) r1 = __popcll(m1 & ltm);
                if (e2 == e) r2 = c1 + __popcll(m2 & ltm); }
            int base = 0;
            if (lane < 16) base = (int)__hip_atomic_fetch_add((unsigned*)(F.ctl() + CW_CNT + (l * 16 + lane) * 64), (unsigned)mycnt, __ATOMIC_RELAXED, __HIP_MEMORY_SCOPE_AGENT);
            const int pos1 = __shfl(base, e1) + r1, pos2 = __shfl(base, e2) + r2;
            const int tok = blk * 64 + lane;
            etok[e1 * M + pos1] = tok; etok[e2 * M + pos2] = tok;
            u32x4 ti; ti.x = (unsigned)(e1 | (e2 << 8)); ti.y = (unsigned)pos1; ti.z = (unsigned)pos2; ti.w = p1b; tokinfo[tok] = ti;
        }
        __syncthreads();
    }
}
__device__ __forceinline__ void load_pref(Frame& F, int l, volatile LAS int* pref) {
    if (F.tid == 0) { int p = 0;
        for (int e = 0; e < 16; ++e) { pref[e] = p; const unsigned c = __hip_atomic_load((unsigned*)(F.ctl() + CW_CNT + (l * 16 + e) * 64), __ATOMIC_RELAXED, __HIP_MEMORY_SCOPE_AGENT); p += (int)((c + 255u) >> 8); }
        pref[16] = p < MAX_RT ? p : MAX_RT; }
    __syncthreads();
}
__device__ __forceinline__ void phase_ln2(Frame& F, int l, bool dry) {
    volatile LAS int* pref = (volatile LAS int*)(F.lds + MISC_OFF + 64);
    load_pref(F, l, pref);
    const int lane = F.lane;
    f32x4 g[4], b[4];
#pragma unroll
    for (int j = 0; j < 4; ++j) { g[j] = *(const f32x4*)(F.in(IN_L2G) + (size_t)l * DM + 256 * j + 4 * lane); b[j] = *(const f32x4*)(F.in(IN_L2B) + (size_t)l * DM + 256 * j + 4 * lane); }
    const bf16_t* YS = (const bf16_t*)(F.ws() + WS_PA + PA_YS); q8_t* XQ = (q8_t*)(F.ws() + (dry ? WS_OPS + 64 * MiB : WS_XB)); float* XS = (float*)(F.ws() + (dry ? WS_OPS + 80 * MiB : WS_XS)); float* xo = dry ? (float*)(F.ws() + WS_OPS) : F.out(); const u32x4* tokinfo = (const u32x4*)(F.ws() + WS_TOKINFO);
    const int gw = F.bid * 8 + F.wave, NGW = F.G * 8;
    for (int row = gw; row < M; row += NGW) {
        const u32x4 ti = tokinfo[row]; const int e1 = ti.x & 255, e2 = (ti.x >> 8) & 255; const float p1 = __uint_as_float(ti.w), p2 = 1.0f - p1;
        const size_t s1 = (size_t)pref[e1] * 256 + ti.y, s2 = (size_t)pref[e2] * 256 + ti.z;
        float* xr = F.out() + (size_t)row * DM; f32x4 v[4]; float s = 0.f;
#pragma unroll
        for (int j = 0; j < 4; ++j) { const f32x4 x1 = *(const f32x4*)(xr + 256 * j + 4 * lane);
            const u32x2 ya = *(const u32x2*)(YS + s1 * DM + 256 * j + 4 * lane), yb = *(const u32x2*)(YS + s2 * DM + 256 * j + 4 * lane);
            v[j][0] = ALPHA * x1[0] + p1 * bf2f(ya.x & 0xffffu) + p2 * bf2f(yb.x & 0xffffu); v[j][1] = ALPHA * x1[1] + p1 * bf2f(ya.x >> 16) + p2 * bf2f(yb.x >> 16);
            v[j][2] = ALPHA * x1[2] + p1 * bf2f(ya.y & 0xffffu) + p2 * bf2f(yb.y & 0xffffu); v[j][3] = ALPHA * x1[3] + p1 * bf2f(ya.y >> 16) + p2 * bf2f(yb.y >> 16);
            s += (v[j][0] + v[j][1]) + (v[j][2] + v[j][3]); }
        const float mean = wave_sum(s) * (1.f / DM); float s2q = 0.f;
#pragma unroll
        for (int j = 0; j < 4; ++j) { v[j] = v[j] - mean; s2q += (v[j][0] * v[j][0] + v[j][1] * v[j][1]) + (v[j][2] * v[j][2] + v[j][3] * v[j][3]); }
        const float rstd = 1.f / sqrtf(wave_sum(s2q) * (1.f / DM) + LN_EPS);
#pragma unroll
        for (int j = 0; j < 4; ++j) { v[j] = v[j] * rstd * g[j] + b[j]; *(f32x4*)(xo + (size_t)row * DM + 256 * j + 4 * lane) = v[j]; }
        if (l + 1 < DEPTH) store_q8_row(XQ + (size_t)row * DM, XS + row, v, lane);
    }
}

__global__ void __launch_bounds__(512, 2) mk_fwd(Args args) {
    extern __shared__ __attribute__((aligned(16))) unsigned char lds_raw[];
    Frame F;
    F.lds = (LAS unsigned char*)lds_raw; F.MISC = (volatile LAS unsigned*)(F.lds + MISC_OFF);
    F.tid = threadIdx.x; F.lane = F.tid & 63; F.wave = __builtin_amdgcn_readfirstlane(F.tid >> 6); F.G = gridDim.x; F.bid = blockIdx.x;
    const CAS Args* kap = (const CAS Args*)__builtin_amdgcn_kernarg_segment_ptr(); F.ap = kap;
    for (int u = F.tid; u < (LDS_BYTES - LDSCTL_OFF) / 4; u += 512) ((LAS unsigned*)(F.lds + LDSCTL_OFF))[u] = 0u;
    __syncthreads();
    const int lo = kap->ph_lo, hi = kap->ph_hi;
    XcdBarrier bar; bar.bar = (unsigned*)(F.ctl() + CW_BAR) + kap->region * XCD_BAR_WORDS; bar.x = 0; bar.st = nullptr;
    if (hi - lo > 1) bar = xcd_barrier_post((unsigned*)(F.ctl() + CW_BAR) + kap->region * XCD_BAR_WORDS, F.MISC + 8);
#ifndef PHASE_ENABLE
#define PHASE_ENABLE 0x3ff
#endif
#define DUP(id) for (int rep_ = 0; rep_ < (((DUP_MASK) >> (id)) & 1) + 1; ++rep_)
#define IN_(k) (((PHASE_ENABLE >> ((k) - p0)) & 1) && lo <= (k) && (k) < hi)
#define SEAM(k) do { if (lo <= (k) && (k) + 1 < hi) { XcdBarrier b_; b_.st = bar.st; b_.x = __builtin_amdgcn_readfirstlane(bar.x); b_.bar = (unsigned*)(F.ctl() + CW_BAR) + F.ap->region * XCD_BAR_WORDS; asm volatile("" : "+s"(b_.x)); xcd_barrier(b_); if ((DUP_MASK) & 0x400) xcd_barrier(b_); } } while (0)
    volatile LAS int* pref = (volatile LAS int*)(F.lds + MISC_OFF + 64);
#define REFRESH() asm volatile("" : "+s"(kap)); F.ap = kap; { int t_ = threadIdx.x, b_ = __builtin_amdgcn_readfirstlane((int)blockIdx.x), g_ = __builtin_amdgcn_readfirstlane((int)gridDim.x); asm volatile("" : "+v"(t_), "+s"(b_), "+s"(g_)); \
        F.tid = t_; F.lane = t_ & 63; F.wave = __builtin_amdgcn_readfirstlane(t_ >> 6); F.bid = b_; F.G = g_; } unsigned char* ws = F.ws(); unsigned char* wb = ws + WS_WB; (void)wb
#pragma unroll 1
    for (int l = 0; l < DEPTH; ++l) {
        const int p0 = l * NPH;
        if (IN_(p0 + PH_W)) { REFRESH(); DUP(PH_W) phase_convert(F, l); SEAM(p0 + PH_W); }
        if (IN_(p0 + PH_G1A)) { REFRESH();
            pg::ProbDenseQ P{(const char*)(ws + WS_XB), (const char*)(wb + WB_1A), 24, F.G, F.bid}; pg::EpiG1aQ E{(bf16_t*)(ws + WS_PA), (const float*)(wb + WB_BIAS), (const float*)(wb + WB_WS1), (const float*)(ws + WS_XS)};
            DUP(PH_G1A) pg::gemm_phase<pg::ProbDenseQ, pg::EpiG1aQ, true>(F.lds, P, E); SEAM(p0 + PH_G1A); }
        if (IN_(p0 + PH_P2)) { REFRESH(); phase_p2(F, l); SEAM(p0 + PH_P2); }
        if (IN_(p0 + PH_G1B)) { REFRESH();
            pg::ProbDenseQ P{(const char*)(ws + WS_XB), (const char*)(wb + WB_1B), 12, F.G, F.bid}; pg::EpiG1bQ E{(bf16_t*)(ws + WS_PA), (const float*)(wb + WB_BIAS) + 6144, (const float*)(wb + WB_WS1) + 6144, (const float*)(ws + WS_XS)};
            DUP(PH_G1B) pg::gemm_phase<pg::ProbDenseQ, pg::EpiG1bQ, true>(F.lds, P, E); SEAM(p0 + PH_G1B); }
        if (IN_(p0 + PH_P3)) { REFRESH();
            pg::ProbP3 P{(const char*)(ws + WS_OPS), (const char*)(wb + WB_WA), (const char*)(wb + WB_WBB), (const char*)(wb + WB_WC), F.G, F.bid}; pg::EpiP3 E{(const bf16_t*)(ws + WS_PA), (bf16_t*)(ws + WS_XB)};
            DUP(PH_P3) pg::gemm_phase<pg::ProbP3, pg::EpiP3, false>(F.lds, P, E); SEAM(p0 + PH_P3); }
        if (IN_(p0 + PH_P4)) { REFRESH();
            pg::ProbDense P{(const char*)(ws + WS_XB), (const char*)(wb + WB_WO), 4, F.G, F.bid}; pg::EpiP4 E{l == 0 ? F.in(IN_X) : (const float*)F.out(), F.out(), F.in(IN_BO) + (size_t)l * DM};
            pg::gemm_phase<pg::ProbDense, pg::EpiP4, false>(F.lds, P, E); SEAM(p0 + PH_P4); }
        if (IN_(p0 + PH_LN1)) { REFRESH(); if ((DUP_MASK >> PH_LN1) & 1) phase_ln1r(F, l, true); phase_ln1r(F, l, false); SEAM(p0 + PH_LN1); }
        if (IN_(p0 + PH_UP)) { REFRESH();
            load_pref(F, l, pref);
            typedef pg::ProbMoe<512, 512, 8, true, (((DUP_MASK) >> PH_UP) & 1) + 1, true> PU; PU P{(const char*)(ws + WS_XB), (const char*)(wb + WB_UP), (const int*)(ws + WS_ETOK), pref, F.G, F.bid};
            pg::EpiUpQ E{(bf16_t*)(ws + WS_PA + PA_H), (const float*)(wb + WB_WSUP), (const float*)(ws + WS_XS), (const int*)(ws + WS_ETOK)};
            pg::gemm_phase<PU, pg::EpiUpQ, true>(F.lds, P, E); SEAM(p0 + PH_UP); }
        if (IN_(p0 + PH_DN)) { REFRESH();
            load_pref(F, l, pref);
            typedef pg::ProbMoe<512, 512, 8, false> PD; PD P{(const char*)(ws + WS_PA + PA_H), (const char*)(wb + WB_DN), (const int*)(ws + WS_ETOK), pref, F.G, F.bid}; pg::EpiDown E{(bf16_t*)(ws + WS_PA + PA_YS)};
            DUP(PH_DN) pg::gemm_phase<PD, pg::EpiDown, true>(F.lds, P, E); SEAM(p0 + PH_DN); }
        if (IN_(p0 + PH_LN2)) { REFRESH(); if ((DUP_MASK >> PH_LN2) & 1) phase_ln2(F, l, true); phase_ln2(F, l, false); SEAM(p0 + PH_LN2); }
    }
#undef IN_
#undef SEAM
}

extern "C" void kernel_launch(void* const* d_in, const int* in_sizes, int n_in, void* d_out, int out_size, void* d_ws, size_t ws_size, hipStream_t stream) {
    static int grid = 0;
    if (grid == 0) {
        if (n_in != N_IN || in_sizes[0] != M * DM || out_size != M * DM || ws_size < WS_END) { fprintf(stderr, "kernel_launch: unexpected shapes (n_in %d, in0 %d, out %d, ws %zu)\n", n_in, n_in > 0 ? in_sizes[0] : -1, out_size, ws_size); grid = -1; return; }
        int dev = 0, cus = 0, per_cu = 0;
        if (hipGetDevice(&dev) != hipSuccess || hipDeviceGetAttribute(&cus, hipDeviceAttributeMultiprocessorCount, dev) != hipSuccess) { grid = -1; return; }
        if (hipFuncSetAttribute((const void*)mk_fwd, hipFuncAttributeMaxDynamicSharedMemorySize, LDS_BYTES) != hipSuccess) { fprintf(stderr, "kernel_launch: hipFuncSetAttribute failed\n"); grid = -1; return; }
        if (hipOccupancyMaxActiveBlocksPerMultiprocessor(&per_cu, (const void*)mk_fwd, 512, LDS_BYTES) != hipSuccess || per_cu < 1) fprintf(stderr, "kernel_launch: occupancy query says %d\n", per_cu);
        (void)hipGetLastError();
        grid = cus;
    }
    if (grid < 0) return;
    (void)hipMemsetAsync((char*)d_ws + WS_CTL, 0, ZERO_BYTES, stream);
    Args a{};
    for (int i = 0; i < N_IN; ++i) a.in[i] = (const float*)d_in[i];
    a.out = (float*)d_out; a.ws = (unsigned char*)d_ws;
    a.ph_lo = 0; a.ph_hi = DEPTH * NPH; a.region = 0;
    hipLaunchKernelGGL(mk_fwd, dim3(grid), dim3(512), LDS_BYTES, stream, a);
}
```

```cpp
#include <hip/hip_runtime.h>
#include <cstdio>
#include <cstdint>
#include <type_traits>


#ifndef DUP_MASK
#define DUP_MASK 0
#endif
#define LAS __attribute__((address_space(3)))
#define GAS __attribute__((address_space(1)))
typedef unsigned short bf16_t;
typedef short bf16x8 __attribute__((ext_vector_type(8)));
typedef float f32x4 __attribute__((ext_vector_type(4)));
typedef float f32x2 __attribute__((ext_vector_type(2)));
typedef unsigned u32x4 __attribute__((ext_vector_type(4)));
typedef unsigned u32x2 __attribute__((ext_vector_type(2)));
typedef int i32x4 __attribute__((ext_vector_type(4)));
typedef signed char q8_t;
typedef GAS unsigned gu32;

constexpr int BATCH = 8, SEQ = 2048, DM = 1024, M = BATCH * SEQ, DEPTH = 2, INC = 9216, NEXP = 16, DE = 512;
constexpr float LN_EPS = 1e-5f;
constexpr float ALPHA = 1.4142135623730951f;
constexpr int NPH = 10;
enum { PH_W = 0, PH_G1A = 1, PH_P2 = 2, PH_G1B = 3, PH_P3 = 4, PH_P4 = 5, PH_LN1 = 6, PH_UP = 7, PH_DN = 8, PH_LN2 = 9 };
enum { IN_X = 0, IN_WIN, IN_BIN, IN_CAW, IN_CAB, IN_LAG, IN_LAB, IN_WA, IN_CBW, IN_WB, IN_WC, IN_CS, IN_WO, IN_BO, IN_L1G, IN_L1B, IN_WR, IN_BR, IN_WG, IN_WU, IN_WD, IN_L2G, IN_L2B, N_IN };

constexpr size_t MiB = 1u << 20;
constexpr size_t WS_CTL = 0;
constexpr size_t CTL_WORDS_BYTES = 262144, WS_ETOK = 262144, ETOK_BYTES = (size_t)NEXP * M * 4, ZERO_BYTES = CTL_WORDS_BYTES + ETOK_BYTES;
constexpr size_t WS_ZERO = 256000;
constexpr size_t WS_TOKINFO = 2 * MiB;
constexpr size_t WS_XS = 3 * MiB;
constexpr size_t WS_WB = 4 * MiB;
constexpr size_t WB_1A = 0, WB_1B = 12 * MiB, WB_WA = 18 * MiB, WB_WBB = 20 * MiB, WB_WC = 22 * MiB, WB_WO = 24 * MiB, WB_UP = 26 * MiB, WB_DN = 58 * MiB, WB_BIAS = 74 * MiB, WB_WS1 = WB_BIAS + 65536, WB_WSUP = WB_BIAS + 131072;
constexpr size_t WS_XB = 80 * MiB;
constexpr size_t WS_PA = 112 * MiB;
constexpr size_t WS_OPS = 240 * MiB;
constexpr size_t WS_END = 336 * MiB;
constexpr size_t PA_H = 0, PA_YS = 40 * MiB;
constexpr int SLOT_ROWS = 36864, MAX_RT = SLOT_ROWS / 256;
constexpr int LDPA = 4096, LDOPS = 1024; constexpr size_t OPS_SEG = (size_t)M * 1024;
constexpr int CW_TMO = 0, CW_CODE = 1, CW_CNT = 1024, CW_BAR = 4096;

constexpr int RING_BYTES = 131072, LDSCTL_OFF = 159744, MISC_OFF = LDSCTL_OFF + 320, LDS_BYTES = 163840;

__device__ __forceinline__ float bf2f(unsigned b) { return __uint_as_float(b << 16); }
__device__ __forceinline__ unsigned f2bf(float f) { unsigned u = __float_as_uint(f); return (u + 0x7fffu + ((u >> 16) & 1u)) >> 16; }
__device__ __forceinline__ unsigned pk2(float lo, float hi) { return f2bf(lo) | (f2bf(hi) << 16); }
__device__ __forceinline__ unsigned cvt_pk_bf16(float lo, float hi) { unsigned r; asm volatile("v_cvt_pk_bf16_f32 %0, %1, %2" : "=v"(r) : "v"(lo), "v"(hi)); return r; }
__device__ __forceinline__ float sigmoidf_(float x) { return __builtin_amdgcn_rcpf(1.0f + __builtin_amdgcn_exp2f(-1.4426950408889634f * x)); }
__device__ __forceinline__ float siluf_(float x) { return x * sigmoidf_(x); }
__device__ __forceinline__ float gate_clamp(float x) { return fmaxf(sigmoidf_(x), 1e-20f); }
template <int CTRL> __device__ __forceinline__ float dppf(float x) { return __builtin_bit_cast(float, __builtin_amdgcn_mov_dpp(__builtin_bit_cast(int, x), CTRL, 0xf, 0xf, true)); }
constexpr int DPP_XOR1 = 0xB1, DPP_XOR2 = 0x4E, DPP_XOR7 = 0x141, DPP_XOR8 = 0x128, DPP_ROR4 = 0x124;
__device__ __forceinline__ float xrow16_sum(float x) {
    auto s = __builtin_amdgcn_permlane16_swap(__float_as_uint(x), __float_as_uint(x), false, false);
    x = __uint_as_float(s[0]) + __uint_as_float(s[1]);
    auto t = __builtin_amdgcn_permlane32_swap(__float_as_uint(x), __float_as_uint(x), false, false);
    return __uint_as_float(t[0]) + __uint_as_float(t[1]);
}
__device__ __forceinline__ float wave_sum(float v) {
    v += dppf<DPP_XOR1>(v); v += dppf<DPP_XOR2>(v); v += dppf<DPP_XOR7>(v); v += dppf<DPP_XOR8>(v);
    return xrow16_sum(v);
}
__device__ __forceinline__ void unpack8(const u32x4 w, float (&f)[8]) {
    f[0] = __uint_as_float(w.x << 16); f[1] = __uint_as_float(w.x & 0xffff0000u); f[2] = __uint_as_float(w.y << 16); f[3] = __uint_as_float(w.y & 0xffff0000u);
    f[4] = __uint_as_float(w.z << 16); f[5] = __uint_as_float(w.z & 0xffff0000u); f[6] = __uint_as_float(w.w << 16); f[7] = __uint_as_float(w.w & 0xffff0000u);
}
__host__ __device__ __forceinline__ int src1a(int n) {
    const int pn = n >> 8, r = n & 255;
    if (pn < 8) return r < 128 ? 128 * pn + r : 1024 + 128 * pn + (r - 128);
    if (pn < 16) { const int q = pn - 8; return r < 128 ? 3072 + 128 * q + r : 4096 + 128 * q + (r - 128); }
    if (pn < 20) return 5120 + 256 * (pn - 16) + r;
    return 2048 + 256 * (pn - 20) + r;
}
struct Route { int e1, e2; float p1; };
__device__ __forceinline__ Route route16(const float (&lg)[16]) {
    float mx = lg[0];
#pragma unroll
    for (int e = 1; e < 16; ++e) mx = fmaxf(mx, lg[e]);
    float pr[16];
#pragma unroll
    for (int e = 0; e < 16; ++e) pr[e] = __expf(lg[e] - mx);
    int bg = 0; float bs = -1.f, ba = 0.f, bb = 0.f, bc = 0.f, bd = 0.f;
#pragma unroll
    for (int g = 0; g < 4; ++g) {
        const float a = pr[4 * g], b = pr[4 * g + 1], c = pr[4 * g + 2], d = pr[4 * g + 3];
        const float m1 = fmaxf(a, b), n1 = fminf(a, b), m2 = fmaxf(c, d), n2 = fminf(c, d);
        const float gs = fmaxf(m1, m2) + fmaxf(fminf(m1, m2), fmaxf(n1, n2));
        if (gs > bs) { bs = gs; bg = g; ba = a; bb = b; bc = c; bd = d; }
    }
    int i1 = 0; float v1 = ba;
    if (bb > v1) { v1 = bb; i1 = 1; } if (bc > v1) { v1 = bc; i1 = 2; } if (bd > v1) { v1 = bd; i1 = 3; }
    int i2 = -1; float v2 = -1.f;
    if (i1 != 0 && ba > v2) { v2 = ba; i2 = 0; } if (i1 != 1 && bb > v2) { v2 = bb; i2 = 1; } if (i1 != 2 && bc > v2) { v2 = bc; i2 = 2; } if (i1 != 3 && bd > v2) { v2 = bd; i2 = 3; }
    Route r; r.e1 = 4 * bg + i1; r.e2 = 4 * bg + i2; r.p1 = v1 / (v1 + v2); return r;
}

#define XB_TMO      128
#define XB_XCNT(j)  (256  + 64 * (j))
#define XB_XSUB(j)  (1280 + 64 * (j))
#define XB_XGEN(j)  (2304 + 64 * (j))
#define XB_TOP      3328
#define XB_TOPGEN   3392
#define XCD_BAR_WORDS 3456
#define XB_SPIN_CAP (1u << 18)
__device__ __forceinline__ unsigned xb_ld(unsigned* p)              { return __hip_atomic_load(p, __ATOMIC_RELAXED, __HIP_MEMORY_SCOPE_AGENT); }
__device__ __forceinline__ unsigned xb_add(unsigned* p, unsigned v) { return __hip_atomic_fetch_add(p, v, __ATOMIC_RELAXED, __HIP_MEMORY_SCOPE_AGENT); }
__device__ __forceinline__ unsigned xb_xcc_id() { return (unsigned)__builtin_amdgcn_s_getreg((3 << 11) | 20) & 0xFu; }
#define XB_SPIN(cond, bar) do { unsigned _sp = 0; while (cond) { __builtin_amdgcn_s_sleep(1); \
    if ((++_sp & 255u) == 0u) { if (xb_ld(&(bar)[XB_TMO])) break; if (_sp > XB_SPIN_CAP) { atomicAdd(&(bar)[XB_TMO], 1u); break; } } } } while (0)
struct XcdBarrier { unsigned* bar; unsigned x; volatile LAS unsigned* st; };
__device__ __forceinline__ XcdBarrier xcd_barrier_post(unsigned* bar, volatile LAS unsigned* st) {
    XcdBarrier b; b.bar = bar; b.x = xb_xcc_id(); b.st = st;
    if (threadIdx.x == 0) (void)xb_add(&bar[XB_XCNT(b.x)], 1u);
    return b;
}
__device__ __forceinline__ void xcd_barrier_complete(unsigned* bar, unsigned x, unsigned& nloc, unsigned& nx) {
    const unsigned G = gridDim.x * gridDim.y * gridDim.z;
    unsigned sum, cnt, mine, sp = 0u;
    for (;;) {
        sum = 0u; cnt = 0u; mine = 0u;
#pragma unroll
        for (unsigned j = 0; j < 16; ++j) { const unsigned c = xb_ld(&bar[XB_XCNT(j)]); sum += c; cnt += (c > 0u) ? 1u : 0u; mine = (j == x) ? c : mine; }
        if (sum == G) break;
        __builtin_amdgcn_s_sleep(1);
        if ((++sp & 255u) == 0u) { if (xb_ld(&bar[XB_TMO])) break; if (sp > XB_SPIN_CAP) { atomicAdd(&bar[XB_TMO], 1u); break; } }
    }
    nloc = mine > 0u ? mine : 1u; nx = cnt > 0u ? cnt : 1u;
}
__device__ __forceinline__ void xcd_barrier(const XcdBarrier& b) {
    asm volatile("s_waitcnt vmcnt(0)" ::: "memory");
    __syncthreads();
    if (threadIdx.x == 0) {
        unsigned* bar = b.bar;
        __builtin_amdgcn_s_waitcnt(0);
        unsigned nloc = b.st[0], nx = b.st[1];
        if (nloc == 0u) { xcd_barrier_complete(bar, b.x, nloc, nx); b.st[0] = nloc; b.st[1] = nx; }
        const unsigned old = xb_add(&bar[XB_XSUB(b.x)], 1u);
        const unsigned gen = old / nloc;
        if (old + 1u == (gen + 1u) * nloc) {
            __builtin_amdgcn_fence(__ATOMIC_RELEASE, "agent");
            asm volatile("s_waitcnt vmcnt(0)" ::: "memory");
            const unsigned og = xb_add(&bar[XB_TOP], 1u);
            const unsigned tg = og / nx;
            if (og + 1u == (tg + 1u) * nx) xb_add(&bar[XB_TOPGEN], 1u);
            else XB_SPIN(xb_ld(&bar[XB_TOPGEN]) == tg, bar);
            __builtin_amdgcn_fence(__ATOMIC_ACQUIRE, "agent");
            xb_add(&bar[XB_XGEN(b.x)], 1u);
            asm volatile("s_waitcnt vmcnt(0)" ::: "memory");
        } else {
            XB_SPIN(xb_ld(&bar[XB_XGEN(b.x)]) == gen, bar);
            __builtin_amdgcn_fence(__ATOMIC_ACQUIRE, "agent");
            asm volatile("s_waitcnt vmcnt(0)" ::: "memory");
        }
    }
    __syncthreads();
}

struct Args { const float* in[N_IN]; float* out; unsigned char* ws; int ph_lo, ph_hi, region, pad1; };
#define CAS __attribute__((address_space(4)))
struct Frame {
    LAS unsigned char* lds; volatile LAS unsigned* MISC;
    int tid, lane, wave, G, bid;
    const CAS Args* ap;
    __device__ __forceinline__ const float* in(int i) const { return ap->in[i]; }
    __device__ __forceinline__ float* out() const { return ap->out; }
    __device__ __forceinline__ unsigned char* ws() const { return ap->ws; }
    __device__ __forceinline__ gu32* ctl() const { return (gu32*)(ap->ws + WS_CTL); }
};
#define LDS_WAIT() asm volatile("s_waitcnt lgkmcnt(0)" ::: "memory")
#define VM_WAIT() asm volatile("s_waitcnt vmcnt(0)" ::: "memory")

namespace pg {
constexpr int BM = 256, BK = 64, HALF = 128, HTB = HALF * BK * 2, STAGE_BYTES = 8 * HTB, NXCD = 8, WGM = 8;
__host__ __device__ __forceinline__ int lds_byte(int r, int c) { const int st = (r >> 4) * 2 + (c >> 5), rr = r & 15, cc = c & 31, ob = rr * 64 + cc * 2; return st * 1024 + (ob ^ (((ob >> 9) & 1) << 5)); }
__host__ __device__ __forceinline__ void stage_rc(int b, int& R, int& C) { const int st = b / 1024, sb = b % 1024, swz = sb ^ (((sb >> 9) & 1) << 5); R = (st >> 1) * 16 + swz / 64; C = (st & 1) * 32 + (swz % 64) / 2; }
__host__ __device__ __forceinline__ int perm32(int rho) { const int n = rho >> 4, i = rho & 15; return 8 * (i >> 2) + 4 * n + (i & 3); }

struct Unit { int pm, pn, e, tb; };
__device__ __forceinline__ bool static_next(int nM, int nN, int G, int c, int i, Unit& u) {
    const int nwg = nM * nN; const long L = (long)i * G + c; if (L >= nwg) return false;
    int wgid = (int)L; { const int q = nwg / NXCD, r = nwg % NXCD, xcd = wgid % NXCD, off = wgid / NXCD; wgid = (xcd < r ? xcd * (q + 1) : r * (q + 1) + (xcd - r) * q) + off; }
    const int nig = WGM * nN, gid = wgid / nig, fm = gid * WGM, gsz = (nM - fm) < WGM ? (nM - fm) : WGM;
    u.pm = fm + ((wgid % nig) % gsz); u.pn = (wgid % nig) / gsz; u.e = 0; u.tb = 0; return true;
}

template <class Prob, class Epi, bool ALIGN_EPI>
__device__ __forceinline__ void gemm_phase(LAS unsigned char* lds, const Prob& P, const Epi& E) {
    int tid_ = threadIdx.x; asm volatile("" : "+v"(tid_));
    const int tid = tid_, wid = __builtin_amdgcn_readfirstlane(tid >> 6), lane = tid & 63, wr = wid >> 2, wc = wid & 3, fr = lane & 15, fq = lane >> 4;
    constexpr int LDA = Prob::LDA, LDB = Prob::LDB;
    constexpr size_t HSTEPA = (size_t)HALF * LDA * 2, HSTEPB = (size_t)HALF * LDB * 2, KSTEP = BK * 2;
    int sR[2], sC[2]; unsigned voffA[2], voffB[2];
#pragma unroll
    for (int i = 0; i < 2; ++i) { stage_rc(tid * 16 + i * 8192, sR[i], sC[i]); const int Rb = Epi::PERM ? ((sR[i] & ~31) + perm32(sR[i] & 31)) : sR[i];
        voffA[i] = (unsigned)(sR[i] * LDA + sC[i]) * 2u; voffB[i] = (unsigned)(Rb * LDB + sC[i]) * 2u; }
    unsigned gc[2][2];
    LAS u32x4* gnl = (LAS u32x4*)(lds + STAGE_BYTES) + tid;
    const unsigned ldsw = (unsigned)wid * 1024u;
    const int aoff = lds_byte(wr * 64 + fr, fq * 8), boff = lds_byte(wc * 32 + fr, fq * 8);
#define PG_SA(b, h) (((b) * 2 + (h)) * HTB)
#define PG_SB(b, h) ((4 + (b) * 2 + (h)) * HTB)
#define PG_GLDS(bufoff, gptr, o0, o1) do { \
        __builtin_amdgcn_global_load_lds((const unsigned*)((const char*)(gptr) + (o0)), (LAS unsigned*)(lds + (bufoff) + ldsw), 16, 0, 0); \
        __builtin_amdgcn_global_load_lds((const unsigned*)((const char*)(gptr) + (o1)), (LAS unsigned*)(lds + (bufoff) + ldsw + 8192), 16, 0, 0); } while (0)
#define PG_STAGE_B(bufoff, gptr) PG_GLDS(bufoff, gptr, voffB[0], voffB[1])
#define PG_STAGE_A(bufoff, gptr, h, NX) do { if constexpr (Prob::GATHER) { PG_GLDS(bufoff, gptr, gc[h][0], gc[h][1]); } \
        else PG_GLDS(bufoff, (const char*)(gptr) + (h) * HSTEPA, voffA[0], voffA[1]); } while (0)
#define PG_LDA(dst, b, h) do { _Pragma("unroll") for (int m = 0; m < 4; ++m) _Pragma("unroll") for (int k = 0; k < 2; ++k) dst[m][k] = *(const LAS bf16x8*)(lds + PG_SA(b, h) + aoff + m * 2048 + k * 1024); } while (0)
#define PG_LDB(dst, b, h) do { _Pragma("unroll") for (int n = 0; n < 2; ++n) _Pragma("unroll") for (int k = 0; k < 2; ++k) dst[n][k] = *(const LAS bf16x8*)(lds + PG_SB(b, h) + boff + n * 2048 + k * 1024); } while (0)
#define PG_MMA(ai, bj, At, Bt) do { __builtin_amdgcn_s_setprio(1); _Pragma("unroll") for (int m = 0; m < 4; ++m) _Pragma("unroll") for (int n = 0; n < 2; ++n) _Pragma("unroll") for (int k = 0; k < 2; ++k) \
        { if constexpr (Prob::I8) acc[ai][bj][m][n] = __builtin_amdgcn_mfma_i32_16x16x64_i8(__builtin_bit_cast(i32x4, Bt[n][k]), __builtin_bit_cast(i32x4, At[m][k]), acc[ai][bj][m][n], 0, 0, 0); \
          else acc[ai][bj][m][n] = __builtin_amdgcn_mfma_f32_16x16x32_bf16(Bt[n][k], At[m][k], acc[ai][bj][m][n], 0, 0, 0); } __builtin_amdgcn_s_setprio(0); } while (0)
#define PG_WAIT_V(n) asm volatile("s_waitcnt vmcnt(" #n ")" ::: "memory")
#define PG_WAIT_L(n) asm volatile("s_waitcnt lgkmcnt(" #n ")" ::: "memory")
#define PG_BAR __builtin_amdgcn_s_barrier()
#define PG_SCHED __builtin_amdgcn_sched_barrier(0)
#define PG_GOFF(dst, u) do { if constexpr (Prob::GATHER) { int t_ = tid; asm volatile("" : "+v"(t_));   \
        _Pragma("unroll") for (int i = 0; i < 2; ++i) { int R_, C_; stage_rc(t_ * 16 + i * 8192, R_, C_); _Pragma("unroll") for (int h = 0; h < 2; ++h) \
        dst[h][i] = (unsigned)(P.tok(u, h * HALF + R_) * LDA + C_) * 2u; } } } while (0)
    Unit cur, nxt; int ui = 0;
    if (!P.next(0, cur)) return;
    typedef typename Prob::AccT AccT;
    AccT acc[2][2][4][2];
#pragma unroll
    for (int a = 0; a < 2; ++a)
#pragma unroll
        for (int b = 0; b < 2; ++b)
#pragma unroll
            for (int m = 0; m < 4; ++m)
#pragma unroll
                for (int n = 0; n < 2; ++n) acc[a][b][m][n] = (AccT){0, 0, 0, 0};
    bf16x8 At[4][2], B0[2][2], B1[2][2];
    PG_GOFF(gc, cur);
    {
        const char* cA0 = P.a_tile(cur, 0); const char* cB0 = P.b_tile(cur, 0); const char* cA1 = P.a_tile(cur, 1); const char* cB1 = P.b_tile(cur, 1);
        PG_STAGE_B(PG_SB(0, 0), cB0); PG_STAGE_B(PG_SB(0, 1), cB0 + HSTEPB); PG_STAGE_A(PG_SA(0, 0), cA0, 0, false); PG_STAGE_A(PG_SA(0, 1), cA0, 1, false);
        if (wr == 1) PG_BAR;
        PG_WAIT_V(2); PG_BAR;
        PG_STAGE_B(PG_SB(1, 0), cB1); PG_STAGE_A(PG_SA(1, 0), cA1, 0, false); PG_STAGE_B(PG_SB(1, 1), cB1 + HSTEPB);
        PG_WAIT_V(6); PG_BAR;
    }
    for (;;) {
        const bool has_next = P.next(ui + 1, nxt);
        if (!has_next) nxt = cur;
        if constexpr (Prob::GATHER) { if (has_next) { unsigned gn[2][2]; PG_GOFF(gn, nxt); *gnl = (u32x4){gn[0][0], gn[0][1], gn[1][0], gn[1][1]}; } }
        const int nt = P.nt(cur);
        for (int t = 0; t < nt; t += 2) {
            const bool last = (t == nt - 2);
            const char* a1 = P.a_tile(cur, t + 1);
            const char* a2 = last ? P.a_tile(nxt, 0) : P.a_tile(cur, t + 2); const char* b2 = last ? P.b_tile(nxt, 0) : P.b_tile(cur, t + 2);
            const char* a3 = last ? P.a_tile(nxt, 1) : P.a_tile(cur, t + 3); const char* b3 = last ? P.b_tile(nxt, 1) : P.b_tile(cur, t + 3);
            PG_LDB(B0, 0, 0); PG_LDB(B1, 0, 1); PG_SCHED; PG_LDA(At, 0, 0); PG_STAGE_A(PG_SA(1, 1), a1, 1, false);
            if constexpr (Prob::GATHER) { if (last && has_next) { const u32x4 g_ = *gnl; gc[0][0] = g_.x; gc[0][1] = g_.y; gc[1][0] = g_.z; gc[1][1] = g_.w; } }
            PG_WAIT_V(8); PG_WAIT_L(0); PG_BAR; PG_MMA(0, 0, At, B0); PG_MMA(0, 1, At, B1); PG_BAR; PG_SCHED;
            PG_LDA(At, 0, 1); PG_STAGE_B(PG_SB(0, 0), b2); PG_STAGE_B(PG_SB(0, 1), b2 + HSTEPB); PG_STAGE_A(PG_SA(0, 0), a2, 0, last);
            PG_WAIT_V(8); PG_WAIT_L(0); PG_BAR; PG_MMA(1, 0, At, B0); PG_MMA(1, 1, At, B1); PG_BAR; PG_SCHED;
            PG_LDB(B0, 1, 0); PG_LDB(B1, 1, 1); PG_SCHED; PG_LDA(At, 1, 0); PG_STAGE_A(PG_SA(0, 1), a2, 1, last);
            PG_WAIT_V(8); PG_WAIT_L(0); PG_BAR; PG_MMA(0, 0, At, B0); PG_MMA(0, 1, At, B1); PG_BAR; PG_SCHED;
            PG_LDA(At, 1, 1); PG_STAGE_B(PG_SB(1, 0), b3); PG_STAGE_B(PG_SB(1, 1), b3 + HSTEPB); PG_STAGE_A(PG_SA(1, 0), a3, 0, last);
            PG_WAIT_V(8); PG_WAIT_L(0); PG_BAR; PG_MMA(1, 0, At, B0); PG_MMA(1, 1, At, B1); PG_BAR; PG_SCHED;
            if constexpr (Prob::NSEG > 1) { const int sg = P.seg_end(t + 2); if (sg >= 0) E.mid(acc, cur, sg, wr, wc, fr, fq); }
        }
        if constexpr (ALIGN_EPI) { if (wr == 0) PG_BAR; }
        E(acc, cur, wr, wc, fr, fq);
        if (!has_next) break;
#pragma unroll
        for (int a = 0; a < 2; ++a)
#pragma unroll
            for (int b = 0; b < 2; ++b)
#pragma unroll
                for (int m = 0; m < 4; ++m)
#pragma unroll
                    for (int n = 0; n < 2; ++n) acc[a][b][m][n] = (AccT){0, 0, 0, 0};
        cur = nxt; ++ui;
        if constexpr (ALIGN_EPI) { if (wr == 1) PG_BAR; }
    }
    PG_WAIT_V(0);
    if constexpr (!ALIGN_EPI) { if (wr == 0) PG_BAR; }
    PG_BAR;
#undef PG_SA
#undef PG_SB
#undef PG_GLDS
#undef PG_STAGE_A
#undef PG_STAGE_B
#undef PG_LDA
#undef PG_LDB
#undef PG_MMA
#undef PG_WAIT_V
#undef PG_WAIT_L
#undef PG_BAR
#undef PG_SCHED
#undef PG_GOFF
}

struct ProbDense {
    static constexpr int LDA = 1024, LDB = 1024, NSEG = 1; static constexpr bool GATHER = false, I8 = false; typedef f32x4 AccT;
    const char* A; const char* Bt; int nN, G, c;
    __device__ __forceinline__ bool next(int i, Unit& u) const { return static_next(M / 256, nN, G, c, i, u); }
    __device__ __forceinline__ int nt(const Unit&) const { return 16; }
    __device__ __forceinline__ const char* a_tile(const Unit& u, int t) const { return A + (size_t)u.pm * (256 * LDA * 2) + t * 128; }
    __device__ __forceinline__ const char* b_tile(const Unit& u, int t) const { return Bt + (size_t)u.pn * (256 * LDB * 2) + t * 128; }
    __device__ __forceinline__ int tok(const Unit&, int) const { return 0; }
    __device__ __forceinline__ int seg_end(int) const { return -1; }
};
struct ProbDenseQ {
    static constexpr int LDA = 512, LDB = 512, NSEG = 1; static constexpr bool GATHER = false, I8 = true; typedef i32x4 AccT;
    const char* A; const char* Bt; int nN, G, c;
    __device__ __forceinline__ bool next(int i, Unit& u) const { return static_next(M / 256, nN, G, c, i, u); }
    __device__ __forceinline__ int nt(const Unit&) const { return 8; }
    __device__ __forceinline__ const char* a_tile(const Unit& u, int t) const { return A + (size_t)u.pm * (256 * LDA * 2) + t * 128; }
    __device__ __forceinline__ const char* b_tile(const Unit& u, int t) const { return Bt + (size_t)u.pn * (256 * LDB * 2) + t * 128; }
    __device__ __forceinline__ int tok(const Unit&, int) const { return 0; }
    __device__ __forceinline__ int seg_end(int) const { return -1; }
};
struct ProbP3 {
    static constexpr int LDA = LDOPS, LDB = 1024, NSEG = 3; static constexpr bool GATHER = false, I8 = false; typedef f32x4 AccT;
    const char* A; const char* Wa; const char* Wb; const char* Wc; int G, c;
    __device__ __forceinline__ bool next(int i, Unit& u) const { return static_next(M / 256, 4, G, c, i, u); }
    __device__ __forceinline__ int nt(const Unit&) const { return 36; }
    __device__ __forceinline__ const char* a_tile(const Unit& u, int t) const {
        const char* base = A + (size_t)u.pm * (256 * LDA * 2);
        return t < 16 ? base + t * 128 : (t < 32 ? base + OPS_SEG * 2 + (t - 16) * 128 : base + 2 * OPS_SEG * 2 + (256 * u.pn) * 2 + (t - 32) * 128); }
    __device__ __forceinline__ const char* b_tile(const Unit& u, int t) const {
        const size_t ro = (size_t)u.pn * (256 * LDB * 2);
        return t < 16 ? Wa + ro + t * 128 : (t < 32 ? Wb + ro + (t - 16) * 128 : Wc + ro + (256 * u.pn) * 2 + (t - 32) * 128); }
    __device__ __forceinline__ int tok(const Unit&, int) const { return 0; }
    __device__ __forceinline__ int seg_end(int t2) const { return t2 == 16 ? 0 : (t2 == 32 ? 1 : -1); }
};
template <int LDA_, int LDB_, int NT_, bool GATHER_, int REP = 1, bool I8_ = false> struct ProbMoe {
    static constexpr int LDA = LDA_, LDB = LDB_, NSEG = 1; static constexpr bool GATHER = GATHER_, I8 = I8_; typedef typename std::conditional<I8_, i32x4, f32x4>::type AccT;
    const char* A; const char* Bt; const int* etok; const volatile LAS int* pref; int G, c;
    __device__ __forceinline__ bool next(int i, Unit& u) const {
        const long L = (long)i * G + c; const int NT = pref[16]; if (L >= 4L * NT * REP) return false;
        const int rtg = (int)(L >> 2) % NT; u.pm = rtg; u.pn = (int)(L & 3); int e = 0;
#pragma unroll
        for (int j = 1; j < 16; ++j) e += (rtg >= pref[j]) ? 1 : 0;
        u.e = e; u.tb = e * M + (rtg - pref[e]) * 256; return true; }
    __device__ __forceinline__ int nt(const Unit&) const { return NT_; }
    __device__ __forceinline__ const char* a_tile(const Unit& u, int t) const { return GATHER ? A + t * 128 : A + (size_t)u.pm * (256 * LDA * 2) + t * 128; }
    __device__ __forceinline__ const char* b_tile(const Unit& u, int t) const { return Bt + ((size_t)u.e * 1024 + (size_t)u.pn * 256) * (LDB * 2) + t * 128; }
    __device__ __forceinline__ int tok(const Unit& u, int r) const { return etok[u.tb + r]; }
    __device__ __forceinline__ int seg_end(int) const { return -1; }
};

__device__ __forceinline__ void st_bf16x8(bf16_t* p, const f32x4 v0, const f32x4 v1) {
    u32x4 w; w.x = cvt_pk_bf16(v0[0], v0[1]); w.y = cvt_pk_bf16(v0[2], v0[3]); w.z = cvt_pk_bf16(v1[0], v1[1]); w.w = cvt_pk_bf16(v1[2], v1[3]); *(u32x4*)p = w; }
__device__ __forceinline__ f32x4 cvt4(const i32x4 a) { return (f32x4){(float)a[0], (float)a[1], (float)a[2], (float)a[3]}; }
struct EpiG1aQ {
    static constexpr bool PERM = true; bf16_t* PA; const float* bias; const float* ws; const float* xs;
    __device__ __forceinline__ void operator()(const i32x4 (&acc)[2][2][4][2], const Unit& u, int wr, int wc, int fr, int fq) const {
        const int row0 = u.pm * BM + wr * 64 + fr, j0 = wc * 32 + 8 * fq; const float* bp = bias + u.pn * 256 + j0; const float* sp = ws + u.pn * 256 + j0;
        f32x4 bv[2][2], cs[2][2];
#pragma unroll
        for (int bj = 0; bj < 2; ++bj)
#pragma unroll
            for (int n = 0; n < 2; ++n) { bv[bj][n] = *(const f32x4*)(bp + bj * HALF + 4 * n); cs[bj][n] = *(const f32x4*)(sp + bj * HALF + 4 * n); }
        float rsv[2][4];
#pragma unroll
        for (int ai = 0; ai < 2; ++ai)
#pragma unroll
            for (int m = 0; m < 4; ++m) rsv[ai][m] = xs[row0 + ai * HALF + m * 16];
        if (u.pn < 16) {
            const bool glu = u.pn < 8; const int oc = (glu ? 128 * u.pn : 1024 + 128 * (u.pn - 8)) + j0;
#pragma unroll
            for (int ai = 0; ai < 2; ++ai)
#pragma unroll
                for (int m = 0; m < 4; ++m) { const int row = row0 + ai * HALF + m * 16; const float rs = rsv[ai][m]; bf16_t* rowp = PA + (size_t)row * LDPA + oc; f32x4 o[2];
#pragma unroll
                    for (int n = 0; n < 2; ++n) { const f32x4 v = cvt4(acc[ai][0][m][n]) * (cs[0][n] * rs) + bv[0][n], g = cvt4(acc[ai][1][m][n]) * (cs[1][n] * rs) + bv[1][n];
#pragma unroll
                        for (int e = 0; e < 4; ++e) o[n][e] = glu ? v[e] * sigmoidf_(g[e]) : v[e] * g[e]; }
                    st_bf16x8(rowp, o[0], o[1]); }
        } else {
            const int oc = (u.pn < 20 ? 2048 + 256 * (u.pn - 16) : 3072 + 256 * (u.pn - 20)) + j0;
#pragma unroll
            for (int ai = 0; ai < 2; ++ai)
#pragma unroll
                for (int m = 0; m < 4; ++m) { const int row = row0 + ai * HALF + m * 16; const float rs = rsv[ai][m]; bf16_t* rowp = PA + (size_t)row * LDPA + oc;
#pragma unroll
                    for (int bj = 0; bj < 2; ++bj) st_bf16x8(rowp + bj * HALF, cvt4(acc[ai][bj][m][0]) * (cs[bj][0] * rs) + bv[bj][0], cvt4(acc[ai][bj][m][1]) * (cs[bj][1] * rs) + bv[bj][1]); }
        }
    }
};
struct EpiG1bQ {
    static constexpr bool PERM = true; bf16_t* PA; const float* bias; const float* ws; const float* xs;
    __device__ __forceinline__ void operator()(const i32x4 (&acc)[2][2][4][2], const Unit& u, int wr, int wc, int fr, int fq) const {
        const int row0 = u.pm * BM + wr * 64 + fr, c0 = u.pn * 256 + wc * 32 + 8 * fq;
        f32x4 bv[2][2], cs[2][2];
#pragma unroll
        for (int bj = 0; bj < 2; ++bj)
#pragma unroll
            for (int n = 0; n < 2; ++n) { bv[bj][n] = *(const f32x4*)(bias + c0 + bj * HALF + 4 * n); cs[bj][n] = *(const f32x4*)(ws + c0 + bj * HALF + 4 * n); }
        float rsv[2][4];
#pragma unroll
        for (int ai = 0; ai < 2; ++ai)
#pragma unroll
            for (int m = 0; m < 4; ++m) rsv[ai][m] = xs[row0 + ai * HALF + m * 16];
#pragma unroll
        for (int ai = 0; ai < 2; ++ai)
#pragma unroll
            for (int m = 0; m < 4; ++m) { const int row = row0 + ai * HALF + m * 16; const float rs = rsv[ai][m]; bf16_t* rowp = PA + (size_t)row * LDPA + c0;
#pragma unroll
                for (int bj = 0; bj < 2; ++bj) { f32x4 o[2];
#pragma unroll
                    for (int n = 0; n < 2; ++n) { const f32x4 v = cvt4(acc[ai][bj][m][n]) * (cs[bj][n] * rs) + bv[bj][n];
#pragma unroll
                        for (int e = 0; e < 4; ++e) o[n][e] = gate_clamp(v[e]); }
                    st_bf16x8(rowp + bj * HALF, o[0], o[1]); } }
    }
};
struct EpiUpQ {
    static constexpr bool PERM = true; bf16_t* H; const float* ws; const float* xs; const int* etok;
    __device__ __forceinline__ void operator()(const i32x4 (&acc)[2][2][4][2], const Unit& u, int wr, int wc, int fr, int fq) const {
        const int rl0 = wr * 64 + fr, j0 = wc * 32 + 8 * fq, oc = 128 * u.pn + j0; const float* sp = ws + u.e * 1024 + u.pn * 256 + j0;
        f32x4 cs[2][2];
#pragma unroll
        for (int bj = 0; bj < 2; ++bj)
#pragma unroll
            for (int n = 0; n < 2; ++n) cs[bj][n] = *(const f32x4*)(sp + bj * HALF + 4 * n);
        int tk[2][4]; float rsv[2][4];
#pragma unroll
        for (int ai = 0; ai < 2; ++ai)
#pragma unroll
            for (int m = 0; m < 4; ++m) tk[ai][m] = etok[u.tb + rl0 + ai * HALF + m * 16];
#pragma unroll
        for (int ai = 0; ai < 2; ++ai)
#pragma unroll
            for (int m = 0; m < 4; ++m) rsv[ai][m] = xs[tk[ai][m]];
#pragma unroll
        for (int ai = 0; ai < 2; ++ai)
#pragma unroll
            for (int m = 0; m < 4; ++m) { const int rl = rl0 + ai * HALF + m * 16; const float rs = rsv[ai][m]; f32x4 o[2];
#pragma unroll
                for (int n = 0; n < 2; ++n) { const f32x4 g = cvt4(acc[ai][0][m][n]) * (cs[0][n] * rs), up = cvt4(acc[ai][1][m][n]) * (cs[1][n] * rs);
#pragma unroll
                    for (int e = 0; e < 4; ++e) o[n][e] = siluf_(g[e]) * up[e]; }
                st_bf16x8(H + (size_t)(u.pm * BM + rl) * DE + oc, o[0], o[1]); }
    }
};
struct EpiG1a {
    static constexpr bool PERM = true; bf16_t* PA; const float* bias;
    __device__ __forceinline__ void operator()(const f32x4 (&acc)[2][2][4][2], const Unit& u, int wr, int wc, int fr, int fq) const {
        const int row0 = u.pm * BM + wr * 64 + fr, j0 = wc * 32 + 8 * fq; const float* bp = bias + u.pn * 256 + j0;
        f32x4 bv[2][2];
#pragma unroll
        for (int bj = 0; bj < 2; ++bj)
#pragma unroll
            for (int n = 0; n < 2; ++n) bv[bj][n] = *(const f32x4*)(bp + bj * HALF + 4 * n);
        if (u.pn < 16) {
            const bool glu = u.pn < 8; const int oc = (glu ? 128 * u.pn : 1024 + 128 * (u.pn - 8)) + j0;
#pragma unroll
            for (int ai = 0; ai < 2; ++ai)
#pragma unroll
                for (int m = 0; m < 4; ++m) { bf16_t* rowp = PA + (size_t)(row0 + ai * HALF + m * 16) * LDPA + oc; f32x4 o[2];
#pragma unroll
                    for (int n = 0; n < 2; ++n) { const f32x4 v = acc[ai][0][m][n] + bv[0][n], g = acc[ai][1][m][n] + bv[1][n];
#pragma unroll
                        for (int e = 0; e < 4; ++e) o[n][e] = glu ? v[e] * sigmoidf_(g[e]) : v[e] * g[e]; }
                    st_bf16x8(rowp, o[0], o[1]); }
        } else {
            const int oc = (u.pn < 20 ? 2048 + 256 * (u.pn - 16) : 3072 + 256 * (u.pn - 20)) + j0;
#pragma unroll
            for (int ai = 0; ai < 2; ++ai)
#pragma unroll
                for (int m = 0; m < 4; ++m) { bf16_t* rowp = PA + (size_t)(row0 + ai * HALF + m * 16) * LDPA + oc;
#pragma unroll
                    for (int bj = 0; bj < 2; ++bj) st_bf16x8(rowp + bj * HALF, acc[ai][bj][m][0] + bv[bj][0], acc[ai][bj][m][1] + bv[bj][1]); }
        }
    }
};
struct EpiG1b {
    static constexpr bool PERM = true; bf16_t* PA; const float* bias;
    __device__ __forceinline__ void operator()(const f32x4 (&acc)[2][2][4][2], const Unit& u, int wr, int wc, int fr, int fq) const {
        const int row0 = u.pm * BM + wr * 64 + fr, c0 = u.pn * 256 + wc * 32 + 8 * fq;
        f32x4 bv[2][2];
#pragma unroll
        for (int bj = 0; bj < 2; ++bj)
#pragma unroll
            for (int n = 0; n < 2; ++n) bv[bj][n] = *(const f32x4*)(bias + c0 + bj * HALF + 4 * n);
#pragma unroll
        for (int ai = 0; ai < 2; ++ai)
#pragma unroll
            for (int m = 0; m < 4; ++m) { bf16_t* rowp = PA + (size_t)(row0 + ai * HALF + m * 16) * LDPA + c0;
#pragma unroll
                for (int bj = 0; bj < 2; ++bj) { f32x4 o[2];
#pragma unroll
                    for (int n = 0; n < 2; ++n) { const f32x4 v = acc[ai][bj][m][n] + bv[bj][n];
#pragma unroll
                        for (int e = 0; e < 4; ++e) o[n][e] = gate_clamp(v[e]); }
                    st_bf16x8(rowp + bj * HALF, o[0], o[1]); } }
    }
};
struct EpiP3 {
    static constexpr bool PERM = true; const bf16_t* GT; bf16_t* O;
    __device__ __forceinline__ void mid(f32x4 (&acc)[2][2][4][2], const Unit& u, int seg, int wr, int wc, int fr, int fq) const {
        int row0 = u.pm * BM + wr * 64 + fr; asm volatile("" : "+v"(row0)); const int c0 = u.pn * 256 + wc * 32 + 8 * fq;
#pragma unroll
        for (int ai = 0; ai < 2; ++ai) { u32x4 nu[4][2], de[4][2];
#pragma unroll
            for (int m = 0; m < 4; ++m) { const bf16_t* gp = GT + (size_t)(row0 + ai * HALF + m * 16) * LDPA + seg * 1024 + c0;
#pragma unroll
                for (int bj = 0; bj < 2; ++bj) { nu[m][bj] = *(const u32x4*)(gp + bj * HALF); de[m][bj] = *(const u32x4*)(gp + 1024 + bj * HALF); } }
#pragma unroll
            for (int m = 0; m < 4; ++m)
#pragma unroll
                for (int bj = 0; bj < 2; ++bj) { float fn[8], fd[8]; unpack8(nu[m][bj], fn); unpack8(de[m][bj], fd);
#pragma unroll
                    for (int e = 0; e < 4; ++e) { acc[ai][bj][m][0][e] *= fn[e] * __builtin_amdgcn_rcpf(fd[e]); acc[ai][bj][m][1][e] *= fn[4 + e] * __builtin_amdgcn_rcpf(fd[4 + e]); } }
            asm volatile("" ::: "memory"); }
    }
    __device__ __forceinline__ void operator()(const f32x4 (&acc)[2][2][4][2], const Unit& u, int wr, int wc, int fr, int fq) const {
        const int row0 = u.pm * BM + wr * 64 + fr, c0 = u.pn * 256 + wc * 32 + 8 * fq;
#pragma unroll
        for (int ai = 0; ai < 2; ++ai) { u32x4 g2[4][2];
#pragma unroll
            for (int m = 0; m < 4; ++m)
#pragma unroll
                for (int bj = 0; bj < 2; ++bj) g2[m][bj] = *(const u32x4*)(GT + (size_t)(row0 + ai * HALF + m * 16) * LDPA + 2048 + c0 + bj * HALF);
#pragma unroll
            for (int m = 0; m < 4; ++m) { const size_t r = (size_t)(row0 + ai * HALF + m * 16);
#pragma unroll
                for (int bj = 0; bj < 2; ++bj) { float fg[8]; unpack8(g2[m][bj], fg); f32x4 o0, o1;
#pragma unroll
                    for (int e = 0; e < 4; ++e) { o0[e] = acc[ai][bj][m][0][e] * fg[e]; o1[e] = acc[ai][bj][m][1][e] * fg[4 + e]; }
                    st_bf16x8(O + r * 1024 + c0 + bj * HALF, o0, o1); } }
            asm volatile("" ::: "memory"); }
    }
};
struct EpiP4 {
    static constexpr bool PERM = true; const float* res32; bf16_t* PB; const float* bias;
    __device__ __forceinline__ void operator()(const f32x4 (&acc)[2][2][4][2], const Unit& u, int wr, int wc, int fr, int fq) const {
        const int row0 = u.pm * BM + wr * 64 + fr, c0 = u.pn * BM + wc * 32 + 8 * fq;
        f32x4 bv[2][2];
#pragma unroll
        for (int bj = 0; bj < 2; ++bj)
#pragma unroll
            for (int n = 0; n < 2; ++n) bv[bj][n] = *(const f32x4*)(bias + c0 + bj * HALF + 4 * n);
#pragma unroll
        for (int ai = 0; ai < 2; ++ai) { f32x4 rs[4][2][2];
            if (res32) {
#pragma unroll
                for (int m = 0; m < 4; ++m) { const size_t off = (size_t)(row0 + ai * HALF + m * 16) * 1024 + c0;
#pragma unroll
                    for (int bj = 0; bj < 2; ++bj)
#pragma unroll
                        for (int n = 0; n < 2; ++n) rs[m][bj][n] = *(const f32x4*)(res32 + off + bj * HALF + 4 * n); }
            } else { u32x4 rb[4][2];
#pragma unroll
                for (int m = 0; m < 4; ++m) { const size_t off = (size_t)(row0 + ai * HALF + m * 16) * 1024 + c0;
#pragma unroll
                    for (int bj = 0; bj < 2; ++bj) rb[m][bj] = *(const u32x4*)(PB + off + bj * HALF); }
#pragma unroll
                for (int m = 0; m < 4; ++m)
#pragma unroll
                    for (int bj = 0; bj < 2; ++bj) { float f[8]; unpack8(rb[m][bj], f); rs[m][bj][0] = (f32x4){f[0], f[1], f[2], f[3]}; rs[m][bj][1] = (f32x4){f[4], f[5], f[6], f[7]}; }
            }
#pragma unroll
            for (int m = 0; m < 4; ++m) { const size_t off = (size_t)(row0 + ai * HALF + m * 16) * 1024 + c0;
#pragma unroll
                for (int bj = 0; bj < 2; ++bj) st_bf16x8(PB + off + bj * HALF, rs[m][bj][0] * ALPHA + acc[ai][bj][m][0] + bv[bj][0], rs[m][bj][1] * ALPHA + acc[ai][bj][m][1] + bv[bj][1]); }
            asm volatile("" ::: "memory"); }
    }
};
struct EpiUp {
    static constexpr bool PERM = true; bf16_t* H;
    __device__ __forceinline__ void operator()(const f32x4 (&acc)[2][2][4][2], const Unit& u, int wr, int wc, int fr, int fq) const {
        const int row0 = u.pm * BM + wr * 64 + fr, oc = 128 * u.pn + wc * 32 + 8 * fq;
#pragma unroll
        for (int ai = 0; ai < 2; ++ai)
#pragma unroll
            for (int m = 0; m < 4; ++m) { f32x4 o[2];
#pragma unroll
                for (int n = 0; n < 2; ++n)
#pragma unroll
                    for (int e = 0; e < 4; ++e) o[n][e] = siluf_(acc[ai][0][m][n][e]) * acc[ai][1][m][n][e];
                st_bf16x8(H + (size_t)(row0 + ai * HALF + m * 16) * DE + oc, o[0], o[1]); }
    }
};
struct EpiDown {
    static constexpr bool PERM = true; bf16_t* YS;
    __device__ __forceinline__ void operator()(const f32x4 (&acc)[2][2][4][2], const Unit& u, int wr, int wc, int fr, int fq) const {
        const int row0 = u.pm * BM + wr * 64 + fr, c0 = u.pn * 256 + wc * 32 + 8 * fq;
#pragma unroll
        for (int ai = 0; ai < 2; ++ai)
#pragma unroll
            for (int m = 0; m < 4; ++m) { bf16_t* rowp = YS + (size_t)(row0 + ai * HALF + m * 16) * 1024 + c0;
#pragma unroll
                for (int bj = 0; bj < 2; ++bj) st_bf16x8(rowp + bj * HALF, acc[ai][bj][m][0], acc[ai][bj][m][1]); }
    }
};
}

__device__ __forceinline__ void tr_item(const float* src, int ld, int k0, int n0, bf16_t* dst, int ldd, int drow0, int dcol0, const float* scale, LAS float* scr, int lane) {
#pragma unroll 8
    for (int i = 0; i < 32; ++i) { const int kk = 2 * i + (lane >> 5); scr[kk * 33 + (lane & 31)] = src[(size_t)(k0 + kk) * ld + n0 + (lane & 31)]; }
    LDS_WAIT(); asm volatile("" ::: "memory");
    const int c = lane & 7;
#pragma unroll
    for (int j = 0; j < 4; ++j) { const int n = (lane >> 3) + 8 * j; const LAS float* s = scr + (8 * c) * 33 + n; const float sc = scale ? scale[drow0 + n] : 1.0f;
        u32x4 o; o.x = pk2(s[0 * 33] * sc, s[1 * 33] * sc); o.y = pk2(s[2 * 33] * sc, s[3 * 33] * sc); o.z = pk2(s[4 * 33] * sc, s[5 * 33] * sc); o.w = pk2(s[6 * 33] * sc, s[7 * 33] * sc);
        *(GAS u32x4*)(dst + (size_t)(drow0 + n) * ldd + dcol0 + k0 + 8 * c) = o; }
    LDS_WAIT(); asm volatile("" ::: "memory");
}
__device__ __forceinline__ float wave_max(float v) {
    v = fmaxf(v, dppf<DPP_XOR1>(v)); v = fmaxf(v, dppf<DPP_XOR2>(v)); v = fmaxf(v, dppf<DPP_XOR7>(v)); v = fmaxf(v, dppf<DPP_XOR8>(v));
    auto s = __builtin_amdgcn_permlane16_swap(__float_as_uint(v), __float_as_uint(v), false, false); v = fmaxf(__uint_as_float(s[0]), __uint_as_float(s[1]));
    auto t = __builtin_amdgcn_permlane32_swap(__float_as_uint(v), __float_as_uint(v), false, false); return fmaxf(__uint_as_float(t[0]), __uint_as_float(t[1]));
}
__device__ __forceinline__ unsigned q8pack(float a, float b, float c, float d) {
    const int qa = (int)__builtin_rintf(a), qb = (int)__builtin_rintf(b), qc = (int)__builtin_rintf(c), qd = (int)__builtin_rintf(d);
    return (unsigned)(qa & 0xff) | ((unsigned)(qb & 0xff) << 8) | ((unsigned)(qc & 0xff) << 16) | ((unsigned)qd << 24);
}
__device__ __forceinline__ void store_q8_row(q8_t* qrow, float* xs, const f32x4 (&v)[4], int lane) {
    float am = 0.f;
#pragma unroll
    for (int j = 0; j < 4; ++j) am = fmaxf(am, fmaxf(fmaxf(fabsf(v[j][0]), fabsf(v[j][1])), fmaxf(fabsf(v[j][2]), fabsf(v[j][3]))));
    am = wave_max(am);
    const float inv = am > 0.f ? 127.0f / am : 0.f;
#pragma unroll
    for (int j = 0; j < 4; ++j) *(unsigned*)(qrow + 256 * j + 4 * lane) = q8pack(v[j][0] * inv, v[j][1] * inv, v[j][2] * inv, v[j][3] * inv);
    if (lane == 0) *xs = am > 0.f ? am * (1.0f / 127.0f) : 1.0f;
}
struct Q8Item { const float* src; int ld, n0; q8_t* dst; int drow0; float* wscale; };
__device__ __forceinline__ void q8_load(const Q8Item& I, int tid, f32x4 (&v)[16]) {
    const float* sp = I.src + (size_t)(4 * (tid >> 3)) * I.ld + I.n0 + 4 * (tid & 7);
#pragma unroll
    for (int p = 0; p < 4; ++p)
#pragma unroll
        for (int r = 0; r < 4; ++r) v[4 * p + r] = *(const f32x4*)(sp + (size_t)(256 * p + r) * I.ld);
}
constexpr int Q8_STRIDE = 1040;
__device__ __forceinline__ void q8_quant(Frame& F, const Q8Item& I, const f32x4 (&v)[16]) {
    LAS float* red = (LAS float*)F.lds;
    LAS unsigned char* qT = F.lds + 1024;
    const int tid = F.tid, b = tid & 7;
    f32x4 am = (f32x4){0.f, 0.f, 0.f, 0.f};
#pragma unroll
    for (int i = 0; i < 16; ++i)
#pragma unroll
        for (int c = 0; c < 4; ++c) am[c] = fmaxf(am[c], fabsf(v[i][c]));
#pragma unroll
    for (int c = 0; c < 4; ++c) { float x = am[c]; x = fmaxf(x, dppf<DPP_XOR8>(x));
        auto s1 = __builtin_amdgcn_permlane16_swap(__float_as_uint(x), __float_as_uint(x), false, false); x = fmaxf(__uint_as_float(s1[0]), __uint_as_float(s1[1]));
        auto s2 = __builtin_amdgcn_permlane32_swap(__float_as_uint(x), __float_as_uint(x), false, false); am[c] = fmaxf(__uint_as_float(s2[0]), __uint_as_float(s2[1])); }
    if (F.lane < 8) *(LAS f32x4*)(red + F.wave * 32 + 4 * b) = am;
    LDS_WAIT(); __syncthreads();
    f32x4 inv;
#pragma unroll
    for (int w = 0; w < 8; ++w) { const f32x4 o = *(const LAS f32x4*)(red + w * 32 + 4 * b);
#pragma unroll
        for (int c = 0; c < 4; ++c) am[c] = fmaxf(am[c], o[c]); }
#pragma unroll
    for (int c = 0; c < 4; ++c) inv[c] = am[c] > 0.f ? 127.0f / am[c] : 0.f;
    if (tid < 8) { f32x4 sc;
#pragma unroll
        for (int c = 0; c < 4; ++c) sc[c] = am[c] > 0.f ? am[c] * (1.0f / 127.0f) : 1.0f;
        *(f32x4*)(I.wscale + I.drow0 + 4 * b) = sc; }
#pragma unroll
    for (int p = 0; p < 4; ++p)
#pragma unroll
        for (int c = 0; c < 4; ++c)
            *(LAS unsigned*)(qT + (4 * b + c) * Q8_STRIDE + 4 * ((tid >> 3) + 64 * p)) = q8pack(v[4 * p][c] * inv[c], v[4 * p + 1][c] * inv[c], v[4 * p + 2][c] * inv[c], v[4 * p + 3][c] * inv[c]);
    LDS_WAIT(); __syncthreads();
}
__device__ __forceinline__ void q8_store(Frame& F, const Q8Item& I) {
    const LAS unsigned char* qT = F.lds + 1024;
#pragma unroll
    for (int j = 0; j < 4; ++j) { const int idx = F.tid + 512 * j, n = idx >> 6, ch = idx & 63;
        *(GAS u32x4*)(I.dst + (size_t)(I.drow0 + n) * 1024 + 16 * ch) = *(const LAS u32x4*)(qT + n * Q8_STRIDE + 16 * ch); }
    LDS_WAIT(); __syncthreads();
}
__device__ __forceinline__ void phase_convert(Frame& F, int l) {
    unsigned char* wb = F.ws() + WS_WB;
    { const float* w_in = F.in(IN_WIN) + (size_t)l * DM * INC; float* ws1 = (float*)(wb + WB_WS1); float* wsup = (float*)(wb + WB_WSUP);
      const float* wg = F.in(IN_WG) + (size_t)l * NEXP * DM * DE; const float* wu = F.in(IN_WU) + (size_t)l * NEXP * DM * DE;
#define Q8_ITEM(I, it) do { if ((it) < 192) I = Q8Item{w_in, INC, src1a(32 * (it)), (q8_t*)(wb + WB_1A), 32 * (it), ws1}; \
          else if ((it) < 288) I = Q8Item{w_in, INC, 6144 + 32 * ((it) - 192), (q8_t*)(wb + WB_1B), 32 * ((it) - 192), ws1 + 6144}; \
          else { const int r_ = (it) - 288, e_ = r_ >> 5, nb_ = r_ & 31, uq_ = nb_ >> 3, rb_ = nb_ & 7; \
              I = Q8Item{(rb_ < 4 ? wg : wu) + (size_t)e_ * DM * DE, DE, 128 * uq_ + 32 * (rb_ & 3), (q8_t*)(wb + WB_UP) + (size_t)e_ * 1024 * 1024, 32 * nb_, wsup + e_ * 1024}; } } while (0)
      constexpr int NQ8 = 192 + 96 + 512;
      f32x4 v[16]; Q8Item cur, nxt; int it = F.bid;
      if (it < NQ8) { Q8_ITEM(cur, it); q8_load(cur, F.tid, v); }
      for (; it < NQ8; it += F.G) {
          q8_quant(F, cur, v);
          const bool more = it + F.G < NQ8;
          if (more) { Q8_ITEM(nxt, it + F.G); q8_load(nxt, F.tid, v); }
          q8_store(F, cur);
          if (more) cur = nxt;
      }
#undef Q8_ITEM
    }
    LAS float* scr = (LAS float*)(F.lds + F.wave * 16384);
    const int gw = F.bid * 8 + F.wave, NGW = F.G * 8;
    constexpr int I_SQ = 32 * 16, I_C = 4 * 32, I_DN = 16 * 256;
    constexpr int NITEMS = 3 * I_SQ + I_C + I_DN;
    for (int it = gw; it < NITEMS; it += NGW) {
        int r = it;
        if (r < 3 * I_SQ) { const int which = r / I_SQ, q = r % I_SQ, nb = q >> 4, kb = q & 15;
            const float* src = (which == 0 ? F.in(IN_WA) : (which == 1 ? F.in(IN_WB) : F.in(IN_WO))) + (size_t)l * DM * DM;
            bf16_t* dst = (bf16_t*)(wb + (which == 0 ? WB_WA : (which == 1 ? WB_WBB : WB_WO)));
            tr_item(src, DM, 64 * kb, 32 * nb, dst, 1024, 32 * nb, 0, nullptr, scr, F.lane); continue; } r -= 3 * I_SQ;
        if (r < I_C) { const int g = r >> 5, q = r & 31, nb = q >> 2, kb = q & 3;
            tr_item(F.in(IN_WC) + ((size_t)l * 4 + g) * 65536, 256, 64 * kb, 32 * nb, (bf16_t*)(wb + WB_WC), 1024, 256 * g + 32 * nb, 256 * g, F.in(IN_CS) + (size_t)l * DM, scr, F.lane); continue; } r -= I_C;
        { const int e = r >> 8, q = r & 255, nb = q >> 3, kb = q & 7;
            tr_item(F.in(IN_WD) + ((size_t)l * NEXP + e) * DE * DM, DM, 64 * kb, 32 * nb, (bf16_t*)(wb + WB_DN) + (size_t)e * 1024 * 512, 512, 32 * nb, 0, nullptr, scr, F.lane); }
    }
    float* bias = (float*)(wb + WB_BIAS); const float* b_in = F.in(IN_BIN) + (size_t)l * INC;
    for (int i = F.bid * 512 + F.tid; i < INC; i += F.G * 512) bias[i] = b_in[i < 6144 ? src1a(i) : i];
    if (l == 0) {
        q8_t* xq = (q8_t*)(F.ws() + WS_XB); float* xs = (float*)(F.ws() + WS_XS);
        for (int row = gw; row < M; row += NGW) { const float* xr = F.in(IN_X) + (size_t)row * DM + 4 * F.lane; f32x4 v[4];
#pragma unroll
            for (int j = 0; j < 4; ++j) v[j] = *(const f32x4*)(xr + 256 * j);
            store_q8_row(xq + (size_t)row * DM, xs + row, v, F.lane); }
    }
}

constexpr int P2_IN_BYTES = 46 * 2048, P2_OUT_OFF = P2_IN_BYTES, P2_TILES = M / 16;
__device__ __forceinline__ void p2_stage(Frame& F, const bf16_t* PA, const unsigned char* zero, int tt) {
    const int grow0 = tt * 16, t0 = grow0 & (SEQ - 1);
#pragma unroll
    for (int i = 0; i < 12; ++i) { const int p = F.wave + 8 * i; if (p < 92) { const int r = p >> 1, half = p & 1;
        const unsigned char* src = (t0 - 30 + r >= 0) ? (const unsigned char*)(PA + (size_t)(grow0 - 30 + r) * LDPA) + half * 1024 : zero;
        __builtin_amdgcn_global_load_lds((const unsigned*)(src + F.lane * 16), (LAS unsigned*)(F.lds + p * 1024), 16, 0, 0); } }
}
__device__ __forceinline__ void phase_p2(Frame& F, int l) {
    const bf16_t* PA = (const bf16_t*)(F.ws() + WS_PA); bf16_t* OPS = (bf16_t*)(F.ws() + WS_OPS);
    const unsigned char* zero = F.ws() + WS_ZERO;
    const int tid = F.tid, lane = F.lane, wave = F.wave;
    LAS unsigned char* lds = F.lds;
    const int pc = tid & 127, rg = tid >> 7;
    const int pw = 2 << (pc >> 5);
    const int nrep = (((DUP_MASK) >> PH_P2) & 1) + 1;
    const int tpb = P2_TILES / F.G; const bool contig = tpb * F.G == P2_TILES;
#define P2_TILE(x) (contig ? ((x) % F.G) * tpb + ((x) / F.G) % tpb : ((x) & (P2_TILES - 1)))
    int tt_ = F.bid;
    if (tt_ < P2_TILES * nrep) p2_stage(F, PA, zero, P2_TILE(tt_));
    for (; tt_ < P2_TILES * nrep; tt_ += F.G) { const int tt = P2_TILE(tt_);
        const int grow0 = tt * 16, t0 = grow0 & (SEQ - 1);
        {   const int r0 = 4 * rg, tb = t0 + r0; const bf16_t* prow = PA + (size_t)(grow0 + r0) * LDPA + 8 * pc;
            u32x4 cu[6], cg[4], cc[19];
#pragma unroll
            for (int k = 0; k < 6; ++k) { cu[k] = (u32x4){0u, 0u, 0u, 0u}; if (tb - 2 + k >= 0) cu[k] = *(const u32x4*)(prow + 1024 + (ptrdiff_t)(k - 2) * LDPA); }
#pragma unroll
            for (int k = 0; k < 4; ++k) cg[k] = *(const u32x4*)(prow + 3072 + (size_t)k * LDPA);
#pragma unroll
            for (int k = 0; k < 19; ++k) { cc[k] = (u32x4){0u, 0u, 0u, 0u}; if (k >= 16 - pw && tb - 15 + k >= 0) cc[k] = *(const u32x4*)(prow + 2048 + (ptrdiff_t)(k - 15) * LDPA); }
            float wb3[3][8];
#pragma unroll
            for (int k = 0; k < 3; ++k) { const f32x4 a = *(const f32x4*)(F.in(IN_CBW) + ((size_t)l * 3 + k) * DM + 8 * pc), b = *(const f32x4*)(F.in(IN_CBW) + ((size_t)l * 3 + k) * DM + 8 * pc + 4);
#pragma unroll
                for (int e = 0; e < 4; ++e) { wb3[k][e] = a[e]; wb3[k][4 + e] = b[e]; } }
#pragma unroll
            for (int i = 0; i < 4; ++i) { float u0[8], u1[8], u2[8], gb[8]; unpack8(cu[i], u0); unpack8(cu[i + 1], u1); unpack8(cu[i + 2], u2); unpack8(cg[i], gb); float o[8];
#pragma unroll
                for (int e = 0; e < 8; ++e) o[e] = gb[e] * (wb3[0][e] * u0[e] + wb3[1][e] * u1[e] + wb3[2][e] * u2[e]);
                u32x4 wv; wv.x = pk2(o[0], o[1]); wv.y = pk2(o[2], o[3]); wv.z = pk2(o[4], o[5]); wv.w = pk2(o[6], o[7]);
                *(u32x4*)(OPS + (size_t)(grow0 + r0 + i) * LDOPS + OPS_SEG + 8 * pc) = wv; }
#pragma unroll
            for (int i = 0; i < 4; ++i) { float s[8], self[8], f[8]; unpack8(cc[15 + i], self);
#pragma unroll
                for (int e = 0; e < 8; ++e) s[e] = self[e];
#pragma unroll
                for (int j = 1; j < 16; ++j) { if (j < pw) { unpack8(cc[15 + i - j], f);
#pragma unroll
                    for (int e = 0; e < 8; ++e) s[e] += f[e]; } }
                const int t = tb + i; const float inv = 1.0f / (float)(t + 1 < pw ? t + 1 : pw);
                u32x4 wv; wv.x = pk2(s[0] * inv - self[0], s[1] * inv - self[1]); wv.y = pk2(s[2] * inv - self[2], s[3] * inv - self[3]);
                wv.z = pk2(s[4] * inv - self[4], s[5] * inv - self[5]); wv.w = pk2(s[6] * inv - self[6], s[7] * inv - self[7]);
                *(u32x4*)(OPS + (size_t)(grow0 + r0 + i) * LDOPS + 2 * OPS_SEG + 8 * pc) = wv; }
        }
        f32x2 w[31]; f32x2 cb;
        { const float* cw = F.in(IN_CAW) + (size_t)l * 31 * DM + 2 * tid; asm volatile("" : "+v"(cw));
#pragma unroll
          for (int k = 0; k < 31; ++k) w[k] = *(const f32x2*)(cw + (size_t)k * DM);
          cb = *(const f32x2*)(F.in(IN_CAB) + (size_t)l * DM + 2 * tid); }
        f32x4 lg[4], lb[4];
#pragma unroll
        for (int q = 0; q < 4; ++q) { lg[q] = *(const f32x4*)(F.in(IN_LAG) + (size_t)l * DM + 256 * q + 4 * lane); lb[q] = *(const f32x4*)(F.in(IN_LAB) + (size_t)l * DM + 256 * q + 4 * lane); }
        VM_WAIT(); __syncthreads();
        f32x2 v[46];
#pragma unroll
        for (int r = 0; r < 46; ++r) { const unsigned bits = *(const LAS unsigned*)(lds + r * 2048 + tid * 4); v[r].x = __uint_as_float(bits << 16); v[r].y = __uint_as_float(bits & 0xffff0000u); }
        LDS_WAIT(); __syncthreads();
        if (tt_ + F.G < P2_TILES * nrep) p2_stage(F, PA, zero, P2_TILE(tt_ + F.G));
#pragma unroll
        for (int o = 0; o < 16; ++o) { f32x2 s = cb;
#pragma unroll
            for (int k = 0; k < 31; ++k) s += w[k] * v[o + k];
            *(LAS f32x2*)(lds + P2_OUT_OFF + o * 4096 + tid * 8) = s; }
        LDS_WAIT(); __builtin_amdgcn_s_barrier(); asm volatile("" ::: "memory");
#pragma unroll
        for (int rr = 0; rr < 2; ++rr) { const int r = wave * 2 + rr; f32x4 x[4]; float s = 0.f;
#pragma unroll
            for (int q = 0; q < 4; ++q) { x[q] = *(const LAS f32x4*)(lds + P2_OUT_OFF + r * 4096 + q * 1024 + lane * 16); s += (x[q][0] + x[q][1]) + (x[q][2] + x[q][3]); }
            const float mean = wave_sum(s) * (1.f / DM); float s2 = 0.f;
#pragma unroll
            for (int q = 0; q < 4; ++q) { x[q] = x[q] - mean; s2 += (x[q][0] * x[q][0] + x[q][1] * x[q][1]) + (x[q][2] * x[q][2] + x[q][3] * x[q][3]); }
            const float rstd = 1.f / sqrtf(wave_sum(s2) * (1.f / DM) + LN_EPS);
            bf16_t* orow = OPS + (size_t)(grow0 + r) * LDOPS;
#pragma unroll
            for (int q = 0; q < 4; ++q) { f32x4 y = x[q] * rstd * lg[q] + lb[q]; u32x2 o; o.x = pk2(siluf_(y[0]), siluf_(y[1])); o.y = pk2(siluf_(y[2]), siluf_(y[3]));
                *(u32x2*)(orow + 256 * q + 4 * lane) = o; } }
    }
    VM_WAIT(); __syncthreads();
}

__device__ __forceinline__ void phase_ln1r(Frame& F, int l, bool dry) {
    LAS float* wr_t = (LAS float*)F.lds;
    LAS int* rinfo = (LAS int*)(F.lds + 65536);
    const int tid = F.tid, lane = F.lane, wave = F.wave;
    { const float* wrg = F.in(IN_WR);
      for (int i = tid; i < DM * 16 / 4; i += 512) { const f32x4 v = *(const f32x4*)(wrg + 4 * i); const int c = i >> 2, e0 = (i & 3) * 4;
#pragma unroll
          for (int e = 0; e < 4; ++e) wr_t[(e0 + e) * DM + c] = v[e]; } }
    f32x4 g[4], b[4];
#pragma unroll
    for (int j = 0; j < 4; ++j) { g[j] = *(const f32x4*)(F.in(IN_L1G) + (size_t)l * DM + 256 * j + 4 * lane); b[j] = *(const f32x4*)(F.in(IN_L1B) + (size_t)l * DM + 256 * j + 4 * lane); }
    float br[16];
#pragma unroll
    for (int e = 0; e < 16; ++e) br[e] = F.in(IN_BR)[e];
    __syncthreads();
    q8_t* XQ = (q8_t*)(F.ws() + (dry ? WS_OPS + 64 * MiB : WS_XB)); float* XS = (float*)(F.ws() + (dry ? WS_OPS + 80 * MiB : WS_XS)); bf16_t* X1B = (bf16_t*)(F.ws() + WS_OPS + (dry ? 32 * MiB : 0));
    const bf16_t* PB = (const bf16_t*)F.out();
    int* etok = (int*)(F.ws() + WS_ETOK); u32x4* tokinfo = (u32x4*)(F.ws() + WS_TOKINFO);
    for (int blk = F.bid; blk < M / 64; blk += F.G) {
        const bf16_t* xin = PB + ((size_t)blk * 64 + wave * 8) * DM + 4 * lane;
        u32x2 vn[4];
#pragma unroll
        for (int j = 0; j < 4; ++j) vn[j] = *(const u32x2*)(xin + 256 * j);
#pragma unroll 1
        for (int rr = 0; rr < 8; ++rr) { const int rl = wave * 8 + rr; const size_t row = (size_t)blk * 64 + rl;
            f32x4 v[4]; float s = 0.f;
#pragma unroll
            for (int j = 0; j < 4; ++j) { v[j] = (f32x4){bf2f(vn[j].x & 0xffffu), bf2f(vn[j].x >> 16), bf2f(vn[j].y & 0xffffu), bf2f(vn[j].y >> 16)}; s += (v[j][0] + v[j][1]) + (v[j][2] + v[j][3]); }
            { const int rn = rr < 7 ? rr + 1 : 7;
#pragma unroll
              for (int j = 0; j < 4; ++j) vn[j] = *(const u32x2*)(xin + (size_t)rn * DM + 256 * j); }
            const float mean = wave_sum(s) * (1.f / DM); float s2 = 0.f;
#pragma unroll
            for (int j = 0; j < 4; ++j) { v[j] = v[j] - mean; s2 += (v[j][0] * v[j][0] + v[j][1] * v[j][1]) + (v[j][2] * v[j][2] + v[j][3] * v[j][3]); }
            const float rstd = 1.f / sqrtf(wave_sum(s2) * (1.f / DM) + LN_EPS);
#pragma unroll
            for (int j = 0; j < 4; ++j) { v[j] = v[j] * rstd * g[j] + b[j]; u32x2 o; o.x = pk2(v[j][0], v[j][1]); o.y = pk2(v[j][2], v[j][3]); *(u32x2*)(X1B + row * DM + 256 * j + 4 * lane) = o; }
            store_q8_row(XQ + row * DM, XS + row, v, lane);
            float a[16];
            const LAS float* wrl = wr_t + 4 * lane; asm volatile("" : "+v"(wrl));
#pragma unroll
            for (int e = 0; e < 16; ++e) { float a0 = 0.f;
#pragma unroll
                for (int j = 0; j < 4; ++j) { const f32x4 wv = *(const LAS f32x4*)(wrl + e * DM + 256 * j); a0 += (v[j][0] * wv[0] + v[j][1] * wv[1]) + (v[j][2] * wv[2] + v[j][3] * wv[3]); }
                a[e] = a0; }
            {
                float t8[8], t4[4], t2[2], t1;
                const bool h0 = (lane & 1) != 0, h1 = (lane & 2) != 0;
#pragma unroll
                for (int i = 0; i < 8; ++i) { auto r = __builtin_amdgcn_permlane32_swap(__float_as_uint(a[i]), __float_as_uint(a[8 + i]), false, false); t8[i] = __uint_as_float(r[0]) + __uint_as_float(r[1]); }
#pragma unroll
                for (int i = 0; i < 4; ++i) { auto r = __builtin_amdgcn_permlane16_swap(__float_as_uint(t8[i]), __float_as_uint(t8[4 + i]), false, false); t4[i] = __uint_as_float(r[0]) + __uint_as_float(r[1]); }
#pragma unroll
                for (int i = 0; i < 2; ++i) t2[i] = (h0 ? t4[2 + i] : t4[i]) + dppf<DPP_XOR1>(h0 ? t4[i] : t4[2 + i]);
                t1 = (h1 ? t2[1] : t2[0]) + dppf<DPP_XOR2>(h1 ? t2[0] : t2[1]);
                t1 += dppf<DPP_ROR4>(t1); t1 += dppf<DPP_XOR8>(t1);
                float lgt[16];
#pragma unroll
                for (int e = 0; e < 16; ++e) lgt[e] = __uint_as_float((unsigned)__builtin_amdgcn_readlane((int)__float_as_uint(t1), 32 * (e >> 3) + 16 * ((e >> 2) & 1) + ((e >> 1) & 1) + 2 * (e & 1))) + br[e];
                const Route rt = route16(lgt);
                if (lane == 0) { rinfo[rl * 4 + 0] = rt.e1; rinfo[rl * 4 + 1] = rt.e2; rinfo[rl * 4 + 2] = (int)__float_as_uint(rt.p1); } }
        }
        __syncthreads();
        if (wave == 0 && !dry) {
            const int e1 = rinfo[lane * 4 + 0], e2 = rinfo[lane * 4 + 1]; const unsigned p1b = (unsigned)rinfo[lane * 4 + 2];
            const unsigned long long ltm = (1ull << lane) - 1ull;
            int mycnt = 0, r1 = 0, r2 = 0;
#pragma unroll
            for (int e = 0; e < 16; ++e) { const unsigned long long m1 = __ballot(e1 == e), m2 = __ballot(e2 == e); const int c1 = __popcll(m1), c2 = __popcll(m2);
                if (lane == e) mycnt = c1 + c2;
                if (e1 == e) r1 = __popcll(m1 & ltm);
                if (e2 == e) r2 = c1 + __popcll(m2 & ltm); }
            int base = 0;
            if (lane < 16) base = (int)__hip_atomic_fetch_add((unsigned*)(F.ctl() + CW_CNT + (l * 16 + lane) * 64), (unsigned)mycnt, __ATOMIC_RELAXED, __HIP_MEMORY_SCOPE_AGENT);
            const int pos1 = __shfl(base, e1) + r1, pos2 = __shfl(base, e2) + r2;
            const int tok = blk * 64 + lane;
            etok[e1 * M + pos1] = tok; etok[e2 * M + pos2] = tok;
            u32x4 ti; ti.x = (unsigned)(e1 | (e2 << 8)); ti.y = (unsigned)pos1; ti.z = (unsigned)pos2; ti.w = p1b; tokinfo[tok] = ti;
        }
        __syncthreads();
    }
}
__device__ __forceinline__ void load_pref(Frame& F, int l, volatile LAS int* pref) {
    if (F.tid == 0) { int p = 0;
        for (int e = 0; e < 16; ++e) { pref[e] = p; const unsigned c = __hip_atomic_load((unsigned*)(F.ctl() + CW_CNT + (l * 16 + e) * 64), __ATOMIC_RELAXED, __HIP_MEMORY_SCOPE_AGENT); p += (int)((c + 255u) >> 8); }
        pref[16] = p < MAX_RT ? p : MAX_RT; }
    __syncthreads();
}
__device__ __forceinline__ void phase_ln2(Frame& F, int l, bool dry) {
    volatile LAS int* pref = (volatile LAS int*)(F.lds + MISC_OFF + 64);
    load_pref(F, l, pref);
    const int lane = F.lane;
    f32x4 g[4], b[4];
#pragma unroll
    for (int j = 0; j < 4; ++j) { g[j] = *(const f32x4*)(F.in(IN_L2G) + (size_t)l * DM + 256 * j + 4 * lane); b[j] = *(const f32x4*)(F.in(IN_L2B) + (size_t)l * DM + 256 * j + 4 * lane); }
    const bf16_t* YS = (const bf16_t*)(F.ws() + WS_PA + PA_YS); q8_t* XQ = (q8_t*)(F.ws() + (dry ? WS_OPS + 64 * MiB : WS_XB)); float* XS = (float*)(F.ws() + (dry ? WS_OPS + 80 * MiB : WS_XS)); float* xo = dry ? (float*)(F.ws() + WS_OPS + 32 * MiB) : F.out(); const bf16_t* X1B = (const bf16_t*)(F.ws() + WS_OPS); const u32x4* tokinfo = (const u32x4*)(F.ws() + WS_TOKINFO);
    const int gw = F.bid * 8 + F.wave, NGW = F.G * 8;
    for (int row = gw; row < M; row += NGW) {
        const u32x4 ti = tokinfo[row]; const int e1 = ti.x & 255, e2 = (ti.x >> 8) & 255; const float p1 = __uint_as_float(ti.w), p2 = 1.0f - p1;
        const size_t s1 = (size_t)pref[e1] * 256 + ti.y, s2 = (size_t)pref[e2] * 256 + ti.z;
        const bf16_t* xr = X1B + (size_t)row * DM; f32x4 v[4]; float s = 0.f;
#pragma unroll
        for (int j = 0; j < 4; ++j) { const u32x2 xb = *(const u32x2*)(xr + 256 * j + 4 * lane); const f32x4 x1 = (f32x4){bf2f(xb.x & 0xffffu), bf2f(xb.x >> 16), bf2f(xb.y & 0xffffu), bf2f(xb.y >> 16)};
            const u32x2 ya = *(const u32x2*)(YS + s1 * DM + 256 * j + 4 * lane), yb = *(const u32x2*)(YS + s2 * DM + 256 * j + 4 * lane);
            v[j][0] = ALPHA * x1[0] + p1 * bf2f(ya.x & 0xffffu) + p2 * bf2f(yb.x & 0xffffu); v[j][1] = ALPHA * x1[1] + p1 * bf2f(ya.x >> 16) + p2 * bf2f(yb.x >> 16);
            v[j][2] = ALPHA * x1[2] + p1 * bf2f(ya.y & 0xffffu) + p2 * bf2f(yb.y & 0xffffu); v[j][3] = ALPHA * x1[3] + p1 * bf2f(ya.y >> 16) + p2 * bf2f(yb.y >> 16);
            s += (v[j][0] + v[j][1]) + (v[j][2] + v[j][3]); }
        const float mean = wave_sum(s) * (1.f / DM); float s2q = 0.f;
#pragma unroll
        for (int j = 0; j < 4; ++j) { v[j] = v[j] - mean; s2q += (v[j][0] * v[j][0] + v[j][1] * v[j][1]) + (v[j][2] * v[j][2] + v[j][3] * v[j][3]); }
        const float rstd = 1.f / sqrtf(wave_sum(s2q) * (1.f / DM) + LN_EPS);
#pragma unroll
        for (int j = 0; j < 4; ++j) v[j] = v[j] * rstd * g[j] + b[j];
        if (l + 1 < DEPTH) {
#pragma unroll
            for (int j = 0; j < 4; ++j) { u32x2 o; o.x = pk2(v[j][0], v[j][1]); o.y = pk2(v[j][2], v[j][3]); *(u32x2*)((bf16_t*)xo + (size_t)row * DM + 256 * j + 4 * lane) = o; }
            store_q8_row(XQ + (size_t)row * DM, XS + row, v, lane);
        } else {
#pragma unroll
            for (int j = 0; j < 4; ++j) *(f32x4*)(xo + (size_t)row * DM + 256 * j + 4 * lane) = v[j];
        }
    }
}

__global__ void __launch_bounds__(512, 2) mk_fwd(Args args) {
    extern __shared__ __attribute__((aligned(16))) unsigned char lds_raw[];
    Frame F;
    F.lds = (LAS unsigned char*)lds_raw; F.MISC = (volatile LAS unsigned*)(F.lds + MISC_OFF);
    F.tid = threadIdx.x; F.lane = F.tid & 63; F.wave = __builtin_amdgcn_readfirstlane(F.tid >> 6); F.G = gridDim.x; F.bid = blockIdx.x;
    const CAS Args* kap = (const CAS Args*)__builtin_amdgcn_kernarg_segment_ptr(); F.ap = kap;
    for (int u = F.tid; u < (LDS_BYTES - LDSCTL_OFF) / 4; u += 512) ((LAS unsigned*)(F.lds + LDSCTL_OFF))[u] = 0u;
    __syncthreads();
    const int lo = kap->ph_lo, hi = kap->ph_hi;
    XcdBarrier bar; bar.bar = (unsigned*)(F.ctl() + CW_BAR) + kap->region * XCD_BAR_WORDS; bar.x = 0; bar.st = nullptr;
    if (hi - lo > 1) bar = xcd_barrier_post((unsigned*)(F.ctl() + CW_BAR) + kap->region * XCD_BAR_WORDS, F.MISC + 8);
#ifndef PHASE_ENABLE
#define PHASE_ENABLE 0x3ff
#endif
#define DUP(id) for (int rep_ = 0; rep_ < (((DUP_MASK) >> (id)) & 1) + 1; ++rep_)
#define IN_(k) (((PHASE_ENABLE >> ((k) - p0)) & 1) && lo <= (k) && (k) < hi)
#define SEAM(k) do { if (lo <= (k) && (k) + 1 < hi) { XcdBarrier b_; b_.st = bar.st; b_.x = __builtin_amdgcn_readfirstlane(bar.x); b_.bar = (unsigned*)(F.ctl() + CW_BAR) + F.ap->region * XCD_BAR_WORDS; asm volatile("" : "+s"(b_.x)); xcd_barrier(b_); if ((DUP_MASK) & 0x400) xcd_barrier(b_); } } while (0)
    volatile LAS int* pref = (volatile LAS int*)(F.lds + MISC_OFF + 64);
#define REFRESH() asm volatile("" : "+s"(kap)); F.ap = kap; { int t_ = threadIdx.x, b_ = __builtin_amdgcn_readfirstlane((int)blockIdx.x), g_ = __builtin_amdgcn_readfirstlane((int)gridDim.x); asm volatile("" : "+v"(t_), "+s"(b_), "+s"(g_)); \
        F.tid = t_; F.lane = t_ & 63; F.wave = __builtin_amdgcn_readfirstlane(t_ >> 6); F.bid = b_; F.G = g_; } unsigned char* ws = F.ws(); unsigned char* wb = ws + WS_WB; (void)wb
#pragma unroll 1
    for (int l = 0; l < DEPTH; ++l) {
        const int p0 = l * NPH;
        if (IN_(p0 + PH_W)) { REFRESH(); DUP(PH_W) { phase_convert(F, l); __syncthreads(); } SEAM(p0 + PH_W); }
        if (IN_(p0 + PH_G1A)) { REFRESH();
            pg::ProbDenseQ P{(const char*)(ws + WS_XB), (const char*)(wb + WB_1A), 24, F.G, F.bid}; pg::EpiG1aQ E{(bf16_t*)(ws + WS_PA), (const float*)(wb + WB_BIAS), (const float*)(wb + WB_WS1), (const float*)(ws + WS_XS)};
            DUP(PH_G1A) pg::gemm_phase<pg::ProbDenseQ, pg::EpiG1aQ, true>(F.lds, P, E); SEAM(p0 + PH_G1A); }
        if (IN_(p0 + PH_P2)) { REFRESH(); phase_p2(F, l); SEAM(p0 + PH_P2); }
        if (IN_(p0 + PH_G1B)) { REFRESH();
            pg::ProbDenseQ P{(const char*)(ws + WS_XB), (const char*)(wb + WB_1B), 12, F.G, F.bid}; pg::EpiG1bQ E{(bf16_t*)(ws + WS_PA), (const float*)(wb + WB_BIAS) + 6144, (const float*)(wb + WB_WS1) + 6144, (const float*)(ws + WS_XS)};
            DUP(PH_G1B) pg::gemm_phase<pg::ProbDenseQ, pg::EpiG1bQ, true>(F.lds, P, E); SEAM(p0 + PH_G1B); }
        if (IN_(p0 + PH_P3)) { REFRESH();
            pg::ProbP3 P{(const char*)(ws + WS_OPS), (const char*)(wb + WB_WA), (const char*)(wb + WB_WBB), (const char*)(wb + WB_WC), F.G, F.bid}; pg::EpiP3 E{(const bf16_t*)(ws + WS_PA), (bf16_t*)(ws + WS_XB)};
            DUP(PH_P3) pg::gemm_phase<pg::ProbP3, pg::EpiP3, false>(F.lds, P, E); SEAM(p0 + PH_P3); }
        if (IN_(p0 + PH_P4)) { REFRESH();
            pg::ProbDense P{(const char*)(ws + WS_XB), (const char*)(wb + WB_WO), 4, F.G, F.bid}; pg::EpiP4 E{l == 0 ? F.in(IN_X) : (const float*)nullptr, (bf16_t*)F.out(), F.in(IN_BO) + (size_t)l * DM};
            pg::gemm_phase<pg::ProbDense, pg::EpiP4, false>(F.lds, P, E); if (((DUP_MASK) >> PH_P4) & 1) { if (l == 0) pg::gemm_phase<pg::ProbDense, pg::EpiP4, false>(F.lds, P, E); } SEAM(p0 + PH_P4); }
        if (IN_(p0 + PH_LN1)) { REFRESH(); if ((DUP_MASK >> PH_LN1) & 1) phase_ln1r(F, l, true); phase_ln1r(F, l, false); SEAM(p0 + PH_LN1); }
        if (IN_(p0 + PH_UP)) { REFRESH();
            load_pref(F, l, pref);
            typedef pg::ProbMoe<512, 512, 8, true, (((DUP_MASK) >> PH_UP) & 1) + 1, true> PU; PU P{(const char*)(ws + WS_XB), (const char*)(wb + WB_UP), (const int*)(ws + WS_ETOK), pref, F.G, F.bid};
            pg::EpiUpQ E{(bf16_t*)(ws + WS_PA + PA_H), (const float*)(wb + WB_WSUP), (const float*)(ws + WS_XS), (const int*)(ws + WS_ETOK)};
            pg::gemm_phase<PU, pg::EpiUpQ, true>(F.lds, P, E); SEAM(p0 + PH_UP); }
        if (IN_(p0 + PH_DN)) { REFRESH();
            load_pref(F, l, pref);
            typedef pg::ProbMoe<512, 512, 8, false> PD; PD P{(const char*)(ws + WS_PA + PA_H), (const char*)(wb + WB_DN), (const int*)(ws + WS_ETOK), pref, F.G, F.bid}; pg::EpiDown E{(bf16_t*)(ws + WS_PA + PA_YS)};
            DUP(PH_DN) pg::gemm_phase<PD, pg::EpiDown, true>(F.lds, P, E); SEAM(p0 + PH_DN); }
        if (IN_(p0 + PH_LN2)) { REFRESH(); if ((DUP_MASK >> PH_LN2) & 1) phase_ln2(F, l, true); phase_ln2(F, l, false); SEAM(p0 + PH_LN2); }
    }
#undef IN_
#undef SEAM
}

extern "C" void kernel_launch(void* const* d_in, const int* in_sizes, int n_in, void* d_out, int out_size, void* d_ws, size_t ws_size, hipStream_t stream) {
    static int grid = 0;
    if (grid == 0) {
        if (n_in != N_IN || in_sizes[0] != M * DM || out_size != M * DM || ws_size < WS_END) { fprintf(stderr, "kernel_launch: unexpected shapes (n_in %d, in0 %d, out %d, ws %zu)\n", n_in, n_in > 0 ? in_sizes[0] : -1, out_size, ws_size); grid = -1; return; }
        int dev = 0, cus = 0, per_cu = 0;
        if (hipGetDevice(&dev) != hipSuccess || hipDeviceGetAttribute(&cus, hipDeviceAttributeMultiprocessorCount, dev) != hipSuccess) { grid = -1; return; }
        if (hipFuncSetAttribute((const void*)mk_fwd, hipFuncAttributeMaxDynamicSharedMemorySize, LDS_BYTES) != hipSuccess) { fprintf(stderr, "kernel_launch: hipFuncSetAttribute failed\n"); grid = -1; return; }
        if (hipOccupancyMaxActiveBlocksPerMultiprocessor(&per_cu, (const void*)mk_fwd, 512, LDS_BYTES) != hipSuccess || per_cu < 1) fprintf(stderr, "kernel_launch: occupancy query says %d\n", per_cu);
        (void)hipGetLastError();
        grid = cus;
    }
    if (grid < 0) return;
    (void)hipMemsetAsync((char*)d_ws + WS_CTL, 0, ZERO_BYTES, stream);
    Args a{};
    for (int i = 0; i < N_IN; ++i) a.in[i] = (const float*)d_in[i];
    a.out = (float*)d_out; a.ws = (unsigned char*)d_ws;
    a.ph_lo = 0; a.ph_hi = DEPTH * NPH; a.region = 0;
    hipLaunchKernelGGL(mk_fwd, dim3(grid), dim3(512), LDS_BYTES, stream, a);
}
```

```cpp
#include <hip/hip_runtime.h>
#include <cstdio>
#include <cstdint>
#include <type_traits>


#ifndef DUP_MASK
#define DUP_MASK 0
#endif
#define LAS __attribute__((address_space(3)))
#define GAS __attribute__((address_space(1)))
typedef unsigned short bf16_t;
typedef short bf16x8 __attribute__((ext_vector_type(8)));
typedef float f32x4 __attribute__((ext_vector_type(4)));
typedef float f32x2 __attribute__((ext_vector_type(2)));
typedef unsigned u32x4 __attribute__((ext_vector_type(4)));
typedef unsigned u32x2 __attribute__((ext_vector_type(2)));
typedef int i32x4 __attribute__((ext_vector_type(4)));
typedef signed char q8_t;
typedef GAS unsigned gu32;

constexpr int BATCH = 8, SEQ = 2048, DM = 1024, M = BATCH * SEQ, DEPTH = 2, INC = 9216, NEXP = 16, DE = 512;
constexpr float LN_EPS = 1e-5f;
constexpr float ALPHA = 1.4142135623730951f;
constexpr int NPH = 10;
enum { PH_W = 0, PH_G1A = 1, PH_P2 = 2, PH_G1B = 3, PH_P3 = 4, PH_P4 = 5, PH_LN1 = 6, PH_UP = 7, PH_DN = 8, PH_LN2 = 9 };
enum { IN_X = 0, IN_WIN, IN_BIN, IN_CAW, IN_CAB, IN_LAG, IN_LAB, IN_WA, IN_CBW, IN_WB, IN_WC, IN_CS, IN_WO, IN_BO, IN_L1G, IN_L1B, IN_WR, IN_BR, IN_WG, IN_WU, IN_WD, IN_L2G, IN_L2B, N_IN };

constexpr size_t MiB = 1u << 20;
constexpr size_t WS_CTL = 0;
constexpr size_t CTL_WORDS_BYTES = 262144, WS_ETOK = 262144, ETOK_BYTES = (size_t)NEXP * M * 4, ZERO_BYTES = CTL_WORDS_BYTES + ETOK_BYTES;
constexpr size_t WS_ZERO = 256000;
constexpr size_t WS_TOKINFO = 2 * MiB;
constexpr size_t WS_XS = 3 * MiB;
constexpr size_t WS_WB = 4 * MiB;
constexpr size_t WB_1A = 0, WB_1B = 12 * MiB, WB_WA = 18 * MiB, WB_WBB = 20 * MiB, WB_WC = 22 * MiB, WB_WO = 24 * MiB, WB_UP = 26 * MiB, WB_DN = 58 * MiB, WB_BIAS = 74 * MiB, WB_WS1 = WB_BIAS + 65536, WB_WSUP = WB_BIAS + 131072;
constexpr size_t WS_XB = 80 * MiB;
constexpr size_t WS_PA = 112 * MiB;
constexpr size_t WS_OPS = 240 * MiB;
constexpr size_t WS_END = 336 * MiB;
constexpr size_t PA_H = 0, PA_YS = 40 * MiB;
constexpr int SLOT_ROWS = 36864, MAX_RT = SLOT_ROWS / 256;
constexpr int LDPA = 4096, LDOPS = 1024; constexpr size_t OPS_SEG = (size_t)M * 1024;
constexpr int CW_TMO = 0, CW_CODE = 1, CW_CNT = 1024, CW_BAR = 4096;

constexpr int RING_BYTES = 131072, LDSCTL_OFF = 159744, MISC_OFF = LDSCTL_OFF + 320, LDS_BYTES = 163840;

__device__ __forceinline__ float bf2f(unsigned b) { return __uint_as_float(b << 16); }
__device__ __forceinline__ unsigned f2bf(float f) { unsigned u = __float_as_uint(f); return (u + 0x7fffu + ((u >> 16) & 1u)) >> 16; }
__device__ __forceinline__ unsigned pk2(float lo, float hi) { return f2bf(lo) | (f2bf(hi) << 16); }
__device__ __forceinline__ unsigned cvt_pk_bf16(float lo, float hi) { unsigned r; asm volatile("v_cvt_pk_bf16_f32 %0, %1, %2" : "=v"(r) : "v"(lo), "v"(hi)); return r; }
__device__ __forceinline__ float sigmoidf_(float x) { return __builtin_amdgcn_rcpf(1.0f + __builtin_amdgcn_exp2f(-1.4426950408889634f * x)); }
__device__ __forceinline__ float siluf_(float x) { return x * sigmoidf_(x); }
__device__ __forceinline__ float gate_clamp(float x) { return fmaxf(sigmoidf_(x), 1e-20f); }
template <int CTRL> __device__ __forceinline__ float dppf(float x) { return __builtin_bit_cast(float, __builtin_amdgcn_mov_dpp(__builtin_bit_cast(int, x), CTRL, 0xf, 0xf, true)); }
constexpr int DPP_XOR1 = 0xB1, DPP_XOR2 = 0x4E, DPP_XOR7 = 0x141, DPP_XOR8 = 0x128, DPP_ROR4 = 0x124;
__device__ __forceinline__ float xrow16_sum(float x) {
    auto s = __builtin_amdgcn_permlane16_swap(__float_as_uint(x), __float_as_uint(x), false, false);
    x = __uint_as_float(s[0]) + __uint_as_float(s[1]);
    auto t = __builtin_amdgcn_permlane32_swap(__float_as_uint(x), __float_as_uint(x), false, false);
    return __uint_as_float(t[0]) + __uint_as_float(t[1]);
}
__device__ __forceinline__ float wave_sum(float v) {
    v += dppf<DPP_XOR1>(v); v += dppf<DPP_XOR2>(v); v += dppf<DPP_XOR7>(v); v += dppf<DPP_XOR8>(v);
    return xrow16_sum(v);
}
__device__ __forceinline__ void unpack8(const u32x4 w, float (&f)[8]) {
    f[0] = __uint_as_float(w.x << 16); f[1] = __uint_as_float(w.x & 0xffff0000u); f[2] = __uint_as_float(w.y << 16); f[3] = __uint_as_float(w.y & 0xffff0000u);
    f[4] = __uint_as_float(w.z << 16); f[5] = __uint_as_float(w.z & 0xffff0000u); f[6] = __uint_as_float(w.w << 16); f[7] = __uint_as_float(w.w & 0xffff0000u);
}
__host__ __device__ __forceinline__ int src1a(int n) {
    const int pn = n >> 8, r = n & 255;
    if (pn < 8) return r < 128 ? 128 * pn + r : 1024 + 128 * pn + (r - 128);
    if (pn < 16) { const int q = pn - 8; return r < 128 ? 3072 + 128 * q + r : 4096 + 128 * q + (r - 128); }
    if (pn < 20) return 5120 + 256 * (pn - 16) + r;
    return 2048 + 256 * (pn - 20) + r;
}
struct Route { int e1, e2; float p1; };
__device__ __forceinline__ Route route16(const float (&lg)[16]) {
    float mx = lg[0];
#pragma unroll
    for (int e = 1; e < 16; ++e) mx = fmaxf(mx, lg[e]);
    float pr[16];
#pragma unroll
    for (int e = 0; e < 16; ++e) pr[e] = __expf(lg[e] - mx);
    int bg = 0; float bs = -1.f, ba = 0.f, bb = 0.f, bc = 0.f, bd = 0.f;
#pragma unroll
    for (int g = 0; g < 4; ++g) {
        const float a = pr[4 * g], b = pr[4 * g + 1], c = pr[4 * g + 2], d = pr[4 * g + 3];
        const float m1 = fmaxf(a, b), n1 = fminf(a, b), m2 = fmaxf(c, d), n2 = fminf(c, d);
        const float gs = fmaxf(m1, m2) + fmaxf(fminf(m1, m2), fmaxf(n1, n2));
        if (gs > bs) { bs = gs; bg = g; ba = a; bb = b; bc = c; bd = d; }
    }
    int i1 = 0; float v1 = ba;
    if (bb > v1) { v1 = bb; i1 = 1; } if (bc > v1) { v1 = bc; i1 = 2; } if (bd > v1) { v1 = bd; i1 = 3; }
    int i2 = -1; float v2 = -1.f;
    if (i1 != 0 && ba > v2) { v2 = ba; i2 = 0; } if (i1 != 1 && bb > v2) { v2 = bb; i2 = 1; } if (i1 != 2 && bc > v2) { v2 = bc; i2 = 2; } if (i1 != 3 && bd > v2) { v2 = bd; i2 = 3; }
    Route r; r.e1 = 4 * bg + i1; r.e2 = 4 * bg + i2; r.p1 = v1 / (v1 + v2); return r;
}

#define XB_TMO      128
#define XB_XCNT(j)  (256  + 64 * (j))
#define XB_XSUB(j)  (1280 + 64 * (j))
#define XB_XGEN(j)  (2304 + 64 * (j))
#define XB_TOP      3328
#define XB_TOPGEN   3392
#define XCD_BAR_WORDS 3456
#define XB_SPIN_CAP (1u << 18)
__device__ __forceinline__ unsigned xb_ld(unsigned* p)              { return __hip_atomic_load(p, __ATOMIC_RELAXED, __HIP_MEMORY_SCOPE_AGENT); }
__device__ __forceinline__ unsigned xb_add(unsigned* p, unsigned v) { return __hip_atomic_fetch_add(p, v, __ATOMIC_RELAXED, __HIP_MEMORY_SCOPE_AGENT); }
__device__ __forceinline__ unsigned xb_xcc_id() { return (unsigned)__builtin_amdgcn_s_getreg((3 << 11) | 20) & 0xFu; }
#define XB_SPIN(cond, bar) do { unsigned _sp = 0; while (cond) { __builtin_amdgcn_s_sleep(1); \
    if ((++_sp & 255u) == 0u) { if (xb_ld(&(bar)[XB_TMO])) break; if (_sp > XB_SPIN_CAP) { atomicAdd(&(bar)[XB_TMO], 1u); break; } } } } while (0)
struct XcdBarrier { unsigned* bar; unsigned x; volatile LAS unsigned* st; };
__device__ __forceinline__ XcdBarrier xcd_barrier_post(unsigned* bar, volatile LAS unsigned* st) {
    XcdBarrier b; b.bar = bar; b.x = xb_xcc_id(); b.st = st;
    if (threadIdx.x == 0) (void)xb_add(&bar[XB_XCNT(b.x)], 1u);
    return b;
}
__device__ __forceinline__ void xcd_barrier_complete(unsigned* bar, unsigned x, unsigned& nloc, unsigned& nx) {
    const unsigned G = gridDim.x * gridDim.y * gridDim.z;
    unsigned sum, cnt, mine, sp = 0u;
    for (;;) {
        sum = 0u; cnt = 0u; mine = 0u;
#pragma unroll
        for (unsigned j = 0; j < 16; ++j) { const unsigned c = xb_ld(&bar[XB_XCNT(j)]); sum += c; cnt += (c > 0u) ? 1u : 0u; mine = (j == x) ? c : mine; }
        if (sum == G) break;
        __builtin_amdgcn_s_sleep(1);
        if ((++sp & 255u) == 0u) { if (xb_ld(&bar[XB_TMO])) break; if (sp > XB_SPIN_CAP) { atomicAdd(&bar[XB_TMO], 1u); break; } }
    }
    nloc = mine > 0u ? mine : 1u; nx = cnt > 0u ? cnt : 1u;
}
__device__ __forceinline__ void xcd_barrier(const XcdBarrier& b) {
    asm volatile("s_waitcnt vmcnt(0)" ::: "memory");
    __syncthreads();
    if (threadIdx.x == 0) {
        unsigned* bar = b.bar;
        __builtin_amdgcn_s_waitcnt(0);
        unsigned nloc = b.st[0], nx = b.st[1];
        if (nloc == 0u) { xcd_barrier_complete(bar, b.x, nloc, nx); b.st[0] = nloc; b.st[1] = nx; }
        const unsigned old = xb_add(&bar[XB_XSUB(b.x)], 1u);
        const unsigned gen = old / nloc;
        if (old + 1u == (gen + 1u) * nloc) {
            __builtin_amdgcn_fence(__ATOMIC_RELEASE, "agent");
            asm volatile("s_waitcnt vmcnt(0)" ::: "memory");
            const unsigned og = xb_add(&bar[XB_TOP], 1u);
            const unsigned tg = og / nx;
            if (og + 1u == (tg + 1u) * nx) xb_add(&bar[XB_TOPGEN], 1u);
            else XB_SPIN(xb_ld(&bar[XB_TOPGEN]) == tg, bar);
            __builtin_amdgcn_fence(__ATOMIC_ACQUIRE, "agent");
            xb_add(&bar[XB_XGEN(b.x)], 1u);
            asm volatile("s_waitcnt vmcnt(0)" ::: "memory");
        } else {
            XB_SPIN(xb_ld(&bar[XB_XGEN(b.x)]) == gen, bar);
            __builtin_amdgcn_fence(__ATOMIC_ACQUIRE, "agent");
            asm volatile("s_waitcnt vmcnt(0)" ::: "memory");
        }
    }
    __syncthreads();
}

struct Args { const float* in[N_IN]; float* out; unsigned char* ws; int ph_lo, ph_hi, region, pad1; };
#define CAS __attribute__((address_space(4)))
struct Frame {
    LAS unsigned char* lds; volatile LAS unsigned* MISC;
    int tid, lane, wave, G, bid;
    const CAS Args* ap;
    __device__ __forceinline__ const float* in(int i) const { return ap->in[i]; }
    __device__ __forceinline__ float* out() const { return ap->out; }
    __device__ __forceinline__ unsigned char* ws() const { return ap->ws; }
    __device__ __forceinline__ gu32* ctl() const { return (gu32*)(ap->ws + WS_CTL); }
};
#define LDS_WAIT() asm volatile("s_waitcnt lgkmcnt(0)" ::: "memory")
#define VM_WAIT() asm volatile("s_waitcnt vmcnt(0)" ::: "memory")

namespace pg {
constexpr int BM = 256, BK = 64, HALF = 128, HTB = HALF * BK * 2, STAGE_BYTES = 8 * HTB, NXCD = 8, WGM = 8;
__host__ __device__ __forceinline__ int lds_byte(int r, int c) { const int st = (r >> 4) * 2 + (c >> 5), rr = r & 15, cc = c & 31, ob = rr * 64 + cc * 2; return st * 1024 + (ob ^ (((ob >> 9) & 1) << 5)); }
__host__ __device__ __forceinline__ void stage_rc(int b, int& R, int& C) { const int st = b / 1024, sb = b % 1024, swz = sb ^ (((sb >> 9) & 1) << 5); R = (st >> 1) * 16 + swz / 64; C = (st & 1) * 32 + (swz % 64) / 2; }
__host__ __device__ __forceinline__ int perm32(int rho) { const int n = rho >> 4, i = rho & 15; return 8 * (i >> 2) + 4 * n + (i & 3); }

struct Unit { int pm, pn, e, tb; };
__device__ __forceinline__ bool static_next(int nM, int nN, int G, int c, int i, Unit& u) {
    const int nwg = nM * nN; const long L = (long)i * G + c; if (L >= nwg) return false;
    int wgid = (int)L; { const int q = nwg / NXCD, r = nwg % NXCD, xcd = wgid % NXCD, off = wgid / NXCD; wgid = (xcd < r ? xcd * (q + 1) : r * (q + 1) + (xcd - r) * q) + off; }
    const int nig = WGM * nN, gid = wgid / nig, fm = gid * WGM, gsz = (nM - fm) < WGM ? (nM - fm) : WGM;
    u.pm = fm + ((wgid % nig) % gsz); u.pn = (wgid % nig) / gsz; u.e = 0; u.tb = 0; return true;
}

template <class Prob, class Epi, bool ALIGN_EPI>
__device__ __forceinline__ void gemm_phase(LAS unsigned char* lds, const Prob& P, const Epi& E) {
    int tid_ = threadIdx.x; asm volatile("" : "+v"(tid_));
    const int tid = tid_, wid = __builtin_amdgcn_readfirstlane(tid >> 6), lane = tid & 63, wr = wid >> 2, wc = wid & 3, fr = lane & 15, fq = lane >> 4;
    constexpr int LDA = Prob::LDA, LDB = Prob::LDB;
    constexpr size_t HSTEPA = (size_t)HALF * LDA * 2, HSTEPB = (size_t)HALF * LDB * 2, KSTEP = BK * 2;
    int sR[2], sC[2]; unsigned voffA[2], voffB[2];
#pragma unroll
    for (int i = 0; i < 2; ++i) { stage_rc(tid * 16 + i * 8192, sR[i], sC[i]); const int Rb = Epi::PERM ? ((sR[i] & ~31) + perm32(sR[i] & 31)) : sR[i];
        voffA[i] = (unsigned)(sR[i] * LDA + sC[i]) * 2u; voffB[i] = (unsigned)(Rb * LDB + sC[i]) * 2u; }
    unsigned gc[2][2];
    LAS u32x4* gnl = (LAS u32x4*)(lds + STAGE_BYTES) + tid;
    const unsigned ldsw = (unsigned)wid * 1024u;
    const int aoff = lds_byte(wr * 64 + fr, fq * 8), boff = lds_byte(wc * 32 + fr, fq * 8);
#define PG_SA(b, h) (((b) * 2 + (h)) * HTB)
#define PG_SB(b, h) ((4 + (b) * 2 + (h)) * HTB)
#define PG_GLDS(bufoff, gptr, o0, o1) do { \
        __builtin_amdgcn_global_load_lds((const unsigned*)((const char*)(gptr) + (o0)), (LAS unsigned*)(lds + (bufoff) + ldsw), 16, 0, 0); \
        __builtin_amdgcn_global_load_lds((const unsigned*)((const char*)(gptr) + (o1)), (LAS unsigned*)(lds + (bufoff) + ldsw + 8192), 16, 0, 0); } while (0)
#define PG_STAGE_B(bufoff, gptr) PG_GLDS(bufoff, gptr, voffB[0], voffB[1])
#define PG_STAGE_A(bufoff, gptr, h, NX) do { if constexpr (Prob::GATHER) { PG_GLDS(bufoff, gptr, gc[h][0], gc[h][1]); } \
        else PG_GLDS(bufoff, (const char*)(gptr) + (h) * HSTEPA, voffA[0], voffA[1]); } while (0)
#define PG_LDA(dst, b, h) do { _Pragma("unroll") for (int m = 0; m < 4; ++m) _Pragma("unroll") for (int k = 0; k < 2; ++k) dst[m][k] = *(const LAS bf16x8*)(lds + PG_SA(b, h) + aoff + m * 2048 + k * 1024); } while (0)
#define PG_LDB(dst, b, h) do { _Pragma("unroll") for (int n = 0; n < 2; ++n) _Pragma("unroll") for (int k = 0; k < 2; ++k) dst[n][k] = *(const LAS bf16x8*)(lds + PG_SB(b, h) + boff + n * 2048 + k * 1024); } while (0)
#define PG_MMA(ai, bj, At, Bt) do { __builtin_amdgcn_s_setprio(1); _Pragma("unroll") for (int m = 0; m < 4; ++m) _Pragma("unroll") for (int n = 0; n < 2; ++n) _Pragma("unroll") for (int k = 0; k < 2; ++k) \
        { if constexpr (Prob::I8) acc[ai][bj][m][n] = __builtin_amdgcn_mfma_i32_16x16x64_i8(__builtin_bit_cast(i32x4, Bt[n][k]), __builtin_bit_cast(i32x4, At[m][k]), acc[ai][bj][m][n], 0, 0, 0); \
          else acc[ai][bj][m][n] = __builtin_amdgcn_mfma_f32_16x16x32_bf16(Bt[n][k], At[m][k], acc[ai][bj][m][n], 0, 0, 0); } __builtin_amdgcn_s_setprio(0); } while (0)
#define PG_WAIT_V(n) asm volatile("s_waitcnt vmcnt(" #n ")" ::: "memory")
#define PG_WAIT_L(n) asm volatile("s_waitcnt lgkmcnt(" #n ")" ::: "memory")
#define PG_BAR __builtin_amdgcn_s_barrier()
#define PG_SCHED __builtin_amdgcn_sched_barrier(0)
#define PG_GOFF(dst, u) do { if constexpr (Prob::GATHER) { int t_ = tid; asm volatile("" : "+v"(t_));   \
        _Pragma("unroll") for (int i = 0; i < 2; ++i) { int R_, C_; stage_rc(t_ * 16 + i * 8192, R_, C_); _Pragma("unroll") for (int h = 0; h < 2; ++h) \
        dst[h][i] = (unsigned)(P.tok(u, h * HALF + R_) * LDA + C_) * 2u; } } } while (0)
    Unit cur, nxt; int ui = 0;
    if (!P.next(0, cur)) return;
    typedef typename Prob::AccT AccT;
    AccT acc[2][2][4][2];
#pragma unroll
    for (int a = 0; a < 2; ++a)
#pragma unroll
        for (int b = 0; b < 2; ++b)
#pragma unroll
            for (int m = 0; m < 4; ++m)
#pragma unroll
                for (int n = 0; n < 2; ++n) acc[a][b][m][n] = (AccT){0, 0, 0, 0};
    bf16x8 At[4][2], B0[2][2], B1[2][2];
    PG_GOFF(gc, cur);
    {
        const char* cA0 = P.a_tile(cur, 0); const char* cB0 = P.b_tile(cur, 0); const char* cA1 = P.a_tile(cur, 1); const char* cB1 = P.b_tile(cur, 1);
        PG_STAGE_B(PG_SB(0, 0), cB0); PG_STAGE_B(PG_SB(0, 1), cB0 + HSTEPB); PG_STAGE_A(PG_SA(0, 0), cA0, 0, false); PG_STAGE_A(PG_SA(0, 1), cA0, 1, false);
        if (wr == 1) PG_BAR;
        PG_WAIT_V(2); PG_BAR;
        PG_STAGE_B(PG_SB(1, 0), cB1); PG_STAGE_A(PG_SA(1, 0), cA1, 0, false); PG_STAGE_B(PG_SB(1, 1), cB1 + HSTEPB);
        PG_WAIT_V(6); PG_BAR;
    }
    for (;;) {
        const bool has_next = P.next(ui + 1, nxt);
        if (!has_next) nxt = cur;
        if constexpr (Prob::GATHER) { if (has_next) { unsigned gn[2][2]; PG_GOFF(gn, nxt); *gnl = (u32x4){gn[0][0], gn[0][1], gn[1][0], gn[1][1]}; } }
        const int nt = P.nt(cur);
        for (int t = 0; t < nt; t += 2) {
            const bool last = (t == nt - 2);
            const char* a1 = P.a_tile(cur, t + 1);
            const char* a2 = last ? P.a_tile(nxt, 0) : P.a_tile(cur, t + 2); const char* b2 = last ? P.b_tile(nxt, 0) : P.b_tile(cur, t + 2);
            const char* a3 = last ? P.a_tile(nxt, 1) : P.a_tile(cur, t + 3); const char* b3 = last ? P.b_tile(nxt, 1) : P.b_tile(cur, t + 3);
            PG_LDB(B0, 0, 0); PG_LDB(B1, 0, 1); PG_SCHED; PG_LDA(At, 0, 0); PG_STAGE_A(PG_SA(1, 1), a1, 1, false);
            if constexpr (Prob::GATHER) { if (last && has_next) { const u32x4 g_ = *gnl; gc[0][0] = g_.x; gc[0][1] = g_.y; gc[1][0] = g_.z; gc[1][1] = g_.w; } }
            PG_WAIT_V(8); PG_WAIT_L(0); PG_BAR; PG_MMA(0, 0, At, B0); PG_MMA(0, 1, At, B1); PG_BAR; PG_SCHED;
            PG_LDA(At, 0, 1); PG_STAGE_B(PG_SB(0, 0), b2); PG_STAGE_B(PG_SB(0, 1), b2 + HSTEPB); PG_STAGE_A(PG_SA(0, 0), a2, 0, last);
            PG_WAIT_V(8); PG_WAIT_L(0); PG_BAR; PG_MMA(1, 0, At, B0); PG_MMA(1, 1, At, B1); PG_BAR; PG_SCHED;
            PG_LDB(B0, 1, 0); PG_LDB(B1, 1, 1); PG_SCHED; PG_LDA(At, 1, 0); PG_STAGE_A(PG_SA(0, 1), a2, 1, last);
            PG_WAIT_V(8); PG_WAIT_L(0); PG_BAR; PG_MMA(0, 0, At, B0); PG_MMA(0, 1, At, B1); PG_BAR; PG_SCHED;
            PG_LDA(At, 1, 1); PG_STAGE_B(PG_SB(1, 0), b3); PG_STAGE_B(PG_SB(1, 1), b3 + HSTEPB); PG_STAGE_A(PG_SA(1, 0), a3, 0, last);
            PG_WAIT_V(8); PG_WAIT_L(0); PG_BAR; PG_MMA(1, 0, At, B0); PG_MMA(1, 1, At, B1); PG_BAR; PG_SCHED;
            if constexpr (Prob::NSEG > 1) { const int sg = P.seg_end(t + 2); if (sg >= 0) E.mid(acc, cur, sg, wr, wc, fr, fq); }
        }
        if constexpr (ALIGN_EPI) { if (wr == 0) PG_BAR; }
        E(acc, cur, wr, wc, fr, fq);
        if (!has_next) break;
#pragma unroll
        for (int a = 0; a < 2; ++a)
#pragma unroll
            for (int b = 0; b < 2; ++b)
#pragma unroll
                for (int m = 0; m < 4; ++m)
#pragma unroll
                    for (int n = 0; n < 2; ++n) acc[a][b][m][n] = (AccT){0, 0, 0, 0};
        cur = nxt; ++ui;
        if constexpr (ALIGN_EPI) { if (wr == 1) PG_BAR; }
    }
    PG_WAIT_V(0);
    if constexpr (!ALIGN_EPI) { if (wr == 0) PG_BAR; }
    PG_BAR;
#undef PG_SA
#undef PG_SB
#undef PG_GLDS
#undef PG_STAGE_A
#undef PG_STAGE_B
#undef PG_LDA
#undef PG_LDB
#undef PG_MMA
#undef PG_WAIT_V
#undef PG_WAIT_L
#undef PG_BAR
#undef PG_SCHED
#undef PG_GOFF
}

struct ProbDense {
    static constexpr int LDA = 1024, LDB = 1024, NSEG = 1; static constexpr bool GATHER = false, I8 = false; typedef f32x4 AccT;
    const char* A; const char* Bt; int nN, G, c;
    __device__ __forceinline__ bool next(int i, Unit& u) const { return static_next(M / 256, nN, G, c, i, u); }
    __device__ __forceinline__ int nt(const Unit&) const { return 16; }
    __device__ __forceinline__ const char* a_tile(const Unit& u, int t) const { return A + (size_t)u.pm * (256 * LDA * 2) + t * 128; }
    __device__ __forceinline__ const char* b_tile(const Unit& u, int t) const { return Bt + (size_t)u.pn * (256 * LDB * 2) + t * 128; }
    __device__ __forceinline__ int tok(const Unit&, int) const { return 0; }
    __device__ __forceinline__ int seg_end(int) const { return -1; }
};
struct ProbDenseQ {
    static constexpr int LDA = 512, LDB = 512, NSEG = 1; static constexpr bool GATHER = false, I8 = true; typedef i32x4 AccT;
    const char* A; const char* Bt; int nN, G, c;
    __device__ __forceinline__ bool next(int i, Unit& u) const { return static_next(M / 256, nN, G, c, i, u); }
    __device__ __forceinline__ int nt(const Unit&) const { return 8; }
    __device__ __forceinline__ const char* a_tile(const Unit& u, int t) const { return A + (size_t)u.pm * (256 * LDA * 2) + t * 128; }
    __device__ __forceinline__ const char* b_tile(const Unit& u, int t) const { return Bt + (size_t)u.pn * (256 * LDB * 2) + t * 128; }
    __device__ __forceinline__ int tok(const Unit&, int) const { return 0; }
    __device__ __forceinline__ int seg_end(int) const { return -1; }
};
struct ProbP3 {
    static constexpr int LDA = LDOPS, LDB = 1024, NSEG = 3; static constexpr bool GATHER = false, I8 = false; typedef f32x4 AccT;
    const char* A; const char* Wa; const char* Wb; const char* Wc; int G, c;
    __device__ __forceinline__ bool next(int i, Unit& u) const { return static_next(M / 256, 4, G, c, i, u); }
    __device__ __forceinline__ int nt(const Unit&) const { return 36; }
    __device__ __forceinline__ const char* a_tile(const Unit& u, int t) const {
        const char* base = A + (size_t)u.pm * (256 * LDA * 2);
        return t < 16 ? base + t * 128 : (t < 32 ? base + OPS_SEG * 2 + (t - 16) * 128 : base + 2 * OPS_SEG * 2 + (256 * u.pn) * 2 + (t - 32) * 128); }
    __device__ __forceinline__ const char* b_tile(const Unit& u, int t) const {
        const size_t ro = (size_t)u.pn * (256 * LDB * 2);
        return t < 16 ? Wa + ro + t * 128 : (t < 32 ? Wb + ro + (t - 16) * 128 : Wc + ro + (256 * u.pn) * 2 + (t - 32) * 128); }
    __device__ __forceinline__ int tok(const Unit&, int) const { return 0; }
    __device__ __forceinline__ int seg_end(int t2) const { return t2 == 16 ? 0 : (t2 == 32 ? 1 : -1); }
};
template <int LDA_, int LDB_, int NT_, bool GATHER_, int REP = 1, bool I8_ = false> struct ProbMoe {
    static constexpr int LDA = LDA_, LDB = LDB_, NSEG = 1; static constexpr bool GATHER = GATHER_, I8 = I8_; typedef typename std::conditional<I8_, i32x4, f32x4>::type AccT;
    const char* A; const char* Bt; const int* etok; const volatile LAS int* pref; int G, c;
    __device__ __forceinline__ bool next(int i, Unit& u) const {
        const long L = (long)i * G + c; const int NT = pref[16]; if (L >= 4L * NT * REP) return false;
        const int rtg = (int)(L >> 2) % NT; u.pm = rtg; u.pn = (int)(L & 3); int e = 0;
#pragma unroll
        for (int j = 1; j < 16; ++j) e += (rtg >= pref[j]) ? 1 : 0;
        u.e = e; u.tb = e * M + (rtg - pref[e]) * 256; return true; }
    __device__ __forceinline__ int nt(const Unit&) const { return NT_; }
    __device__ __forceinline__ const char* a_tile(const Unit& u, int t) const { return GATHER ? A + t * 128 : A + (size_t)u.pm * (256 * LDA * 2) + t * 128; }
    __device__ __forceinline__ const char* b_tile(const Unit& u, int t) const { return Bt + ((size_t)u.e * 1024 + (size_t)u.pn * 256) * (LDB * 2) + t * 128; }
    __device__ __forceinline__ int tok(const Unit& u, int r) const { return etok[u.tb + r]; }
    __device__ __forceinline__ int seg_end(int) const { return -1; }
};

__device__ __forceinline__ void st_bf16x8(bf16_t* p, const f32x4 v0, const f32x4 v1) {
    u32x4 w; w.x = cvt_pk_bf16(v0[0], v0[1]); w.y = cvt_pk_bf16(v0[2], v0[3]); w.z = cvt_pk_bf16(v1[0], v1[1]); w.w = cvt_pk_bf16(v1[2], v1[3]); *(u32x4*)p = w; }
__device__ __forceinline__ f32x4 cvt4(const i32x4 a) { return (f32x4){(float)a[0], (float)a[1], (float)a[2], (float)a[3]}; }
struct EpiG1aQ {
    static constexpr bool PERM = true; bf16_t* PA; const float* bias; const float* ws; const float* xs;
    __device__ __forceinline__ void operator()(const i32x4 (&acc)[2][2][4][2], const Unit& u, int wr, int wc, int fr, int fq) const {
        const int row0 = u.pm * BM + wr * 64 + fr, j0 = wc * 32 + 8 * fq; const float* bp = bias + u.pn * 256 + j0; const float* sp = ws + u.pn * 256 + j0;
        f32x4 bv[2][2], cs[2][2];
#pragma unroll
        for (int bj = 0; bj < 2; ++bj)
#pragma unroll
            for (int n = 0; n < 2; ++n) { bv[bj][n] = *(const f32x4*)(bp + bj * HALF + 4 * n); cs[bj][n] = *(const f32x4*)(sp + bj * HALF + 4 * n); }
        float rsv[2][4];
#pragma unroll
        for (int ai = 0; ai < 2; ++ai)
#pragma unroll
            for (int m = 0; m < 4; ++m) rsv[ai][m] = xs[row0 + ai * HALF + m * 16];
        if (u.pn < 16) {
            const bool glu = u.pn < 8; const int oc = (glu ? 128 * u.pn : 1024 + 128 * (u.pn - 8)) + j0;
#pragma unroll
            for (int ai = 0; ai < 2; ++ai)
#pragma unroll
                for (int m = 0; m < 4; ++m) { const int row = row0 + ai * HALF + m * 16; const float rs = rsv[ai][m]; bf16_t* rowp = PA + (size_t)row * LDPA + oc; f32x4 o[2];
#pragma unroll
                    for (int n = 0; n < 2; ++n) { const f32x4 v = cvt4(acc[ai][0][m][n]) * (cs[0][n] * rs) + bv[0][n], g = cvt4(acc[ai][1][m][n]) * (cs[1][n] * rs) + bv[1][n];
#pragma unroll
                        for (int e = 0; e < 4; ++e) o[n][e] = glu ? v[e] * sigmoidf_(g[e]) : v[e] * g[e]; }
                    st_bf16x8(rowp, o[0], o[1]); }
        } else {
            const int oc = (u.pn < 20 ? 2048 + 256 * (u.pn - 16) : 3072 + 256 * (u.pn - 20)) + j0;
#pragma unroll
            for (int ai = 0; ai < 2; ++ai)
#pragma unroll
                for (int m = 0; m < 4; ++m) { const int row = row0 + ai * HALF + m * 16; const float rs = rsv[ai][m]; bf16_t* rowp = PA + (size_t)row * LDPA + oc;
#pragma unroll
                    for (int bj = 0; bj < 2; ++bj) st_bf16x8(rowp + bj * HALF, cvt4(acc[ai][bj][m][0]) * (cs[bj][0] * rs) + bv[bj][0], cvt4(acc[ai][bj][m][1]) * (cs[bj][1] * rs) + bv[bj][1]); }
        }
    }
};
struct EpiG1bQ {
    static constexpr bool PERM = true; bf16_t* PA; const float* bias; const float* ws; const float* xs;
    __device__ __forceinline__ void operator()(const i32x4 (&acc)[2][2][4][2], const Unit& u, int wr, int wc, int fr, int fq) const {
        const int row0 = u.pm * BM + wr * 64 + fr, c0 = u.pn * 256 + wc * 32 + 8 * fq;
        f32x4 bv[2][2], cs[2][2];
#pragma unroll
        for (int bj = 0; bj < 2; ++bj)
#pragma unroll
            for (int n = 0; n < 2; ++n) { bv[bj][n] = *(const f32x4*)(bias + c0 + bj * HALF + 4 * n); cs[bj][n] = *(const f32x4*)(ws + c0 + bj * HALF + 4 * n); }
        float rsv[2][4];
#pragma unroll
        for (int ai = 0; ai < 2; ++ai)
#pragma unroll
            for (int m = 0; m < 4; ++m) rsv[ai][m] = xs[row0 + ai * HALF + m * 16];
#pragma unroll
        for (int ai = 0; ai < 2; ++ai)
#pragma unroll
            for (int m = 0; m < 4; ++m) { const int row = row0 + ai * HALF + m * 16; const float rs = rsv[ai][m]; bf16_t* rowp = PA + (size_t)row * LDPA + c0;
#pragma unroll
                for (int bj = 0; bj < 2; ++bj) { f32x4 o[2];
#pragma unroll
                    for (int n = 0; n < 2; ++n) { const f32x4 v = cvt4(acc[ai][bj][m][n]) * (cs[bj][n] * rs) + bv[bj][n];
#pragma unroll
                        for (int e = 0; e < 4; ++e) o[n][e] = gate_clamp(v[e]); }
                    st_bf16x8(rowp + bj * HALF, o[0], o[1]); } }
    }
};
struct EpiUpQ {
    static constexpr bool PERM = true; bf16_t* H; const float* ws; const float* xs; const int* etok;
    __device__ __forceinline__ void operator()(const i32x4 (&acc)[2][2][4][2], const Unit& u, int wr, int wc, int fr, int fq) const {
        const int rl0 = wr * 64 + fr, j0 = wc * 32 + 8 * fq, oc = 128 * u.pn + j0; const float* sp = ws + u.e * 1024 + u.pn * 256 + j0;
        f32x4 cs[2][2];
#pragma unroll
        for (int bj = 0; bj < 2; ++bj)
#pragma unroll
            for (int n = 0; n < 2; ++n) cs[bj][n] = *(const f32x4*)(sp + bj * HALF + 4 * n);
        int tk[2][4]; float rsv[2][4];
#pragma unroll
        for (int ai = 0; ai < 2; ++ai)
#pragma unroll
            for (int m = 0; m < 4; ++m) tk[ai][m] = etok[u.tb + rl0 + ai * HALF + m * 16];
#pragma unroll
        for (int ai = 0; ai < 2; ++ai)
#pragma unroll
            for (int m = 0; m < 4; ++m) rsv[ai][m] = xs[tk[ai][m]];
#pragma unroll
        for (int ai = 0; ai < 2; ++ai)
#pragma unroll
            for (int m = 0; m < 4; ++m) { const int rl = rl0 + ai * HALF + m * 16; const float rs = rsv[ai][m]; f32x4 o[2];
#pragma unroll
                for (int n = 0; n < 2; ++n) { const f32x4 g = cvt4(acc[ai][0][m][n]) * (cs[0][n] * rs), up = cvt4(acc[ai][1][m][n]) * (cs[1][n] * rs);
#pragma unroll
                    for (int e = 0; e < 4; ++e) o[n][e] = siluf_(g[e]) * up[e]; }
                st_bf16x8(H + (size_t)(u.pm * BM + rl) * DE + oc, o[0], o[1]); }
    }
};
struct EpiG1a {
    static constexpr bool PERM = true; bf16_t* PA; const float* bias;
    __device__ __forceinline__ void operator()(const f32x4 (&acc)[2][2][4][2], const Unit& u, int wr, int wc, int fr, int fq) const {
        const int row0 = u.pm * BM + wr * 64 + fr, j0 = wc * 32 + 8 * fq; const float* bp = bias + u.pn * 256 + j0;
        f32x4 bv[2][2];
#pragma unroll
        for (int bj = 0; bj < 2; ++bj)
#pragma unroll
            for (int n = 0; n < 2; ++n) bv[bj][n] = *(const f32x4*)(bp + bj * HALF + 4 * n);
        if (u.pn < 16) {
            const bool glu = u.pn < 8; const int oc = (glu ? 128 * u.pn : 1024 + 128 * (u.pn - 8)) + j0;
#pragma unroll
            for (int ai = 0; ai < 2; ++ai)
#pragma unroll
                for (int m = 0; m < 4; ++m) { bf16_t* rowp = PA + (size_t)(row0 + ai * HALF + m * 16) * LDPA + oc; f32x4 o[2];
#pragma unroll
                    for (int n = 0; n < 2; ++n) { const f32x4 v = acc[ai][0][m][n] + bv[0][n], g = acc[ai][1][m][n] + bv[1][n];
#pragma unroll
                        for (int e = 0; e < 4; ++e) o[n][e] = glu ? v[e] * sigmoidf_(g[e]) : v[e] * g[e]; }
                    st_bf16x8(rowp, o[0], o[1]); }
        } else {
            const int oc = (u.pn < 20 ? 2048 + 256 * (u.pn - 16) : 3072 + 256 * (u.pn - 20)) + j0;
#pragma unroll
            for (int ai = 0; ai < 2; ++ai)
#pragma unroll
                for (int m = 0; m < 4; ++m) { bf16_t* rowp = PA + (size_t)(row0 + ai * HALF + m * 16) * LDPA + oc;
#pragma unroll
                    for (int bj = 0; bj < 2; ++bj) st_bf16x8(rowp + bj * HALF, acc[ai][bj][m][0] + bv[bj][0], acc[ai][bj][m][1] + bv[bj][1]); }
        }
    }
};
struct EpiG1b {
    static constexpr bool PERM = true; bf16_t* PA; const float* bias;
    __device__ __forceinline__ void operator()(const f32x4 (&acc)[2][2][4][2], const Unit& u, int wr, int wc, int fr, int fq) const {
        const int row0 = u.pm * BM + wr * 64 + fr, c0 = u.pn * 256 + wc * 32 + 8 * fq;
        f32x4 bv[2][2];
#pragma unroll
        for (int bj = 0; bj < 2; ++bj)
#pragma unroll
            for (int n = 0; n < 2; ++n) bv[bj][n] = *(const f32x4*)(bias + c0 + bj * HALF + 4 * n);
#pragma unroll
        for (int ai = 0; ai < 2; ++ai)
#pragma unroll
            for (int m = 0; m < 4; ++m) { bf16_t* rowp = PA + (size_t)(row0 + ai * HALF + m * 16) * LDPA + c0;
#pragma unroll
                for (int bj = 0; bj < 2; ++bj) { f32x4 o[2];
#pragma unroll
                    for (int n = 0; n < 2; ++n) { const f32x4 v = acc[ai][bj][m][n] + bv[bj][n];
#pragma unroll
                        for (int e = 0; e < 4; ++e) o[n][e] = gate_clamp(v[e]); }
                    st_bf16x8(rowp + bj * HALF, o[0], o[1]); } }
    }
};
struct EpiP3 {
    static constexpr bool PERM = true; const bf16_t* GT; bf16_t* O;
    __device__ __forceinline__ void mid(f32x4 (&acc)[2][2][4][2], const Unit& u, int seg, int wr, int wc, int fr, int fq) const {
        int row0 = u.pm * BM + wr * 64 + fr; asm volatile("" : "+v"(row0)); const int c0 = u.pn * 256 + wc * 32 + 8 * fq;
#pragma unroll
        for (int ai = 0; ai < 2; ++ai) { u32x4 nu[4][2], de[4][2];
#pragma unroll
            for (int m = 0; m < 4; ++m) { const bf16_t* gp = GT + (size_t)(row0 + ai * HALF + m * 16) * LDPA + seg * 1024 + c0;
#pragma unroll
                for (int bj = 0; bj < 2; ++bj) { nu[m][bj] = *(const u32x4*)(gp + bj * HALF); de[m][bj] = *(const u32x4*)(gp + 1024 + bj * HALF); } }
#pragma unroll
            for (int m = 0; m < 4; ++m)
#pragma unroll
                for (int bj = 0; bj < 2; ++bj) { float fn[8], fd[8]; unpack8(nu[m][bj], fn); unpack8(de[m][bj], fd);
#pragma unroll
                    for (int e = 0; e < 4; ++e) { acc[ai][bj][m][0][e] *= fn[e] * __builtin_amdgcn_rcpf(fd[e]); acc[ai][bj][m][1][e] *= fn[4 + e] * __builtin_amdgcn_rcpf(fd[4 + e]); } }
            asm volatile("" ::: "memory"); }
    }
    __device__ __forceinline__ void operator()(const f32x4 (&acc)[2][2][4][2], const Unit& u, int wr, int wc, int fr, int fq) const {
        const int row0 = u.pm * BM + wr * 64 + fr, c0 = u.pn * 256 + wc * 32 + 8 * fq;
#pragma unroll
        for (int ai = 0; ai < 2; ++ai) { u32x4 g2[4][2];
#pragma unroll
            for (int m = 0; m < 4; ++m)
#pragma unroll
                for (int bj = 0; bj < 2; ++bj) g2[m][bj] = *(const u32x4*)(GT + (size_t)(row0 + ai * HALF + m * 16) * LDPA + 2048 + c0 + bj * HALF);
#pragma unroll
            for (int m = 0; m < 4; ++m) { const size_t r = (size_t)(row0 + ai * HALF + m * 16);
#pragma unroll
                for (int bj = 0; bj < 2; ++bj) { float fg[8]; unpack8(g2[m][bj], fg); f32x4 o0, o1;
#pragma unroll
                    for (int e = 0; e < 4; ++e) { o0[e] = acc[ai][bj][m][0][e] * fg[e]; o1[e] = acc[ai][bj][m][1][e] * fg[4 + e]; }
                    st_bf16x8(O + r * 1024 + c0 + bj * HALF, o0, o1); } }
            asm volatile("" ::: "memory"); }
    }
};
struct EpiP4 {
    static constexpr bool PERM = true; const float* res32; bf16_t* PB; const float* bias;
    __device__ __forceinline__ void operator()(const f32x4 (&acc)[2][2][4][2], const Unit& u, int wr, int wc, int fr, int fq) const {
        const int row0 = u.pm * BM + wr * 64 + fr, c0 = u.pn * BM + wc * 32 + 8 * fq;
        f32x4 bv[2][2];
#pragma unroll
        for (int bj = 0; bj < 2; ++bj)
#pragma unroll
            for (int n = 0; n < 2; ++n) bv[bj][n] = *(const f32x4*)(bias + c0 + bj * HALF + 4 * n);
#pragma unroll
        for (int ai = 0; ai < 2; ++ai) { f32x4 rs[4][2][2];
            if (res32) {
#pragma unroll
                for (int m = 0; m < 4; ++m) { const size_t off = (size_t)(row0 + ai * HALF + m * 16) * 1024 + c0;
#pragma unroll
                    for (int bj = 0; bj < 2; ++bj)
#pragma unroll
                        for (int n = 0; n < 2; ++n) rs[m][bj][n] = *(const f32x4*)(res32 + off + bj * HALF + 4 * n); }
            } else { u32x4 rb[4][2];
#pragma unroll
                for (int m = 0; m < 4; ++m) { const size_t off = (size_t)(row0 + ai * HALF + m * 16) * 1024 + c0;
#pragma unroll
                    for (int bj = 0; bj < 2; ++bj) rb[m][bj] = *(const u32x4*)(PB + off + bj * HALF); }
#pragma unroll
                for (int m = 0; m < 4; ++m)
#pragma unroll
                    for (int bj = 0; bj < 2; ++bj) { float f[8]; unpack8(rb[m][bj], f); rs[m][bj][0] = (f32x4){f[0], f[1], f[2], f[3]}; rs[m][bj][1] = (f32x4){f[4], f[5], f[6], f[7]}; }
            }
#pragma unroll
            for (int m = 0; m < 4; ++m) { const size_t off = (size_t)(row0 + ai * HALF + m * 16) * 1024 + c0;
#pragma unroll
                for (int bj = 0; bj < 2; ++bj) st_bf16x8(PB + off + bj * HALF, rs[m][bj][0] * ALPHA + acc[ai][bj][m][0] + bv[bj][0], rs[m][bj][1] * ALPHA + acc[ai][bj][m][1] + bv[bj][1]); }
            asm volatile("" ::: "memory"); }
    }
};
struct EpiUp {
    static constexpr bool PERM = true; bf16_t* H;
    __device__ __forceinline__ void operator()(const f32x4 (&acc)[2][2][4][2], const Unit& u, int wr, int wc, int fr, int fq) const {
        const int row0 = u.pm * BM + wr * 64 + fr, oc = 128 * u.pn + wc * 32 + 8 * fq;
#pragma unroll
        for (int ai = 0; ai < 2; ++ai)
#pragma unroll
            for (int m = 0; m < 4; ++m) { f32x4 o[2];
#pragma unroll
                for (int n = 0; n < 2; ++n)
#pragma unroll
                    for (int e = 0; e < 4; ++e) o[n][e] = siluf_(acc[ai][0][m][n][e]) * acc[ai][1][m][n][e];
                st_bf16x8(H + (size_t)(row0 + ai * HALF + m * 16) * DE + oc, o[0], o[1]); }
    }
};
struct EpiDown {
    static constexpr bool PERM = true; bf16_t* YS;
    __device__ __forceinline__ void operator()(const f32x4 (&acc)[2][2][4][2], const Unit& u, int wr, int wc, int fr, int fq) const {
        const int row0 = u.pm * BM + wr * 64 + fr, c0 = u.pn * 256 + wc * 32 + 8 * fq;
#pragma unroll
        for (int ai = 0; ai < 2; ++ai)
#pragma unroll
            for (int m = 0; m < 4; ++m) { bf16_t* rowp = YS + (size_t)(row0 + ai * HALF + m * 16) * 1024 + c0;
#pragma unroll
                for (int bj = 0; bj < 2; ++bj) st_bf16x8(rowp + bj * HALF, acc[ai][bj][m][0], acc[ai][bj][m][1]); }
    }
};
}

__device__ __forceinline__ void tr_item(const float* src, int ld, int k0, int n0, bf16_t* dst, int ldd, int drow0, int dcol0, const float* scale, LAS float* scr, int lane) {
#pragma unroll 8
    for (int i = 0; i < 32; ++i) { const int kk = 2 * i + (lane >> 5); scr[kk * 33 + (lane & 31)] = src[(size_t)(k0 + kk) * ld + n0 + (lane & 31)]; }
    LDS_WAIT(); asm volatile("" ::: "memory");
    const int c = lane & 7;
#pragma unroll
    for (int j = 0; j < 4; ++j) { const int n = (lane >> 3) + 8 * j; const LAS float* s = scr + (8 * c) * 33 + n; const float sc = scale ? scale[drow0 + n] : 1.0f;
        u32x4 o; o.x = pk2(s[0 * 33] * sc, s[1 * 33] * sc); o.y = pk2(s[2 * 33] * sc, s[3 * 33] * sc); o.z = pk2(s[4 * 33] * sc, s[5 * 33] * sc); o.w = pk2(s[6 * 33] * sc, s[7 * 33] * sc);
        *(GAS u32x4*)(dst + (size_t)(drow0 + n) * ldd + dcol0 + k0 + 8 * c) = o; }
    LDS_WAIT(); asm volatile("" ::: "memory");
}
__device__ __forceinline__ float wave_max(float v) {
    v = fmaxf(v, dppf<DPP_XOR1>(v)); v = fmaxf(v, dppf<DPP_XOR2>(v)); v = fmaxf(v, dppf<DPP_XOR7>(v)); v = fmaxf(v, dppf<DPP_XOR8>(v));
    auto s = __builtin_amdgcn_permlane16_swap(__float_as_uint(v), __float_as_uint(v), false, false); v = fmaxf(__uint_as_float(s[0]), __uint_as_float(s[1]));
    auto t = __builtin_amdgcn_permlane32_swap(__float_as_uint(v), __float_as_uint(v), false, false); return fmaxf(__uint_as_float(t[0]), __uint_as_float(t[1]));
}
__device__ __forceinline__ unsigned q8pack(float a, float b, float c, float d) {
    const int qa = (int)__builtin_rintf(a), qb = (int)__builtin_rintf(b), qc = (int)__builtin_rintf(c), qd = (int)__builtin_rintf(d);
    return (unsigned)(qa & 0xff) | ((unsigned)(qb & 0xff) << 8) | ((unsigned)(qc & 0xff) << 16) | ((unsigned)qd << 24);
}
__device__ __forceinline__ void store_q8_row(q8_t* qrow, float* xs, const f32x4 (&v)[4], int lane) {
    float am = 0.f;
#pragma unroll
    for (int j = 0; j < 4; ++j) am = fmaxf(am, fmaxf(fmaxf(fabsf(v[j][0]), fabsf(v[j][1])), fmaxf(fabsf(v[j][2]), fabsf(v[j][3]))));
    am = wave_max(am);
    const float inv = am > 0.f ? 127.0f / am : 0.f;
#pragma unroll
    for (int j = 0; j < 4; ++j) *(unsigned*)(qrow + 256 * j + 4 * lane) = q8pack(v[j][0] * inv, v[j][1] * inv, v[j][2] * inv, v[j][3] * inv);
    if (lane == 0) *xs = am > 0.f ? am * (1.0f / 127.0f) : 1.0f;
}
struct Q8Item { const float* src; int ld, n0; q8_t* dst; int drow0; float* wscale; };
__device__ __forceinline__ void q8_load(const Q8Item& I, int tid, f32x4 (&v)[16]) {
    const float* sp = I.src + (size_t)(4 * (tid >> 3)) * I.ld + I.n0 + 4 * (tid & 7);
#pragma unroll
    for (int p = 0; p < 4; ++p)
#pragma unroll
        for (int r = 0; r < 4; ++r) v[4 * p + r] = *(const f32x4*)(sp + (size_t)(256 * p + r) * I.ld);
}
constexpr int Q8_STRIDE = 1040;
__device__ __forceinline__ void q8_quant(Frame& F, const Q8Item& I, const f32x4 (&v)[16]) {
    LAS float* red = (LAS float*)F.lds;
    LAS unsigned char* qT = F.lds + 1024;
    const int tid = F.tid, b = tid & 7;
    f32x4 am = (f32x4){0.f, 0.f, 0.f, 0.f};
#pragma unroll
    for (int i = 0; i < 16; ++i)
#pragma unroll
        for (int c = 0; c < 4; ++c) am[c] = fmaxf(am[c], fabsf(v[i][c]));
#pragma unroll
    for (int c = 0; c < 4; ++c) { float x = am[c]; x = fmaxf(x, dppf<DPP_XOR8>(x));
        auto s1 = __builtin_amdgcn_permlane16_swap(__float_as_uint(x), __float_as_uint(x), false, false); x = fmaxf(__uint_as_float(s1[0]), __uint_as_float(s1[1]));
        auto s2 = __builtin_amdgcn_permlane32_swap(__float_as_uint(x), __float_as_uint(x), false, false); am[c] = fmaxf(__uint_as_float(s2[0]), __uint_as_float(s2[1])); }
    if (F.lane < 8) *(LAS f32x4*)(red + F.wave * 32 + 4 * b) = am;
    LDS_WAIT(); __syncthreads();
    f32x4 inv;
#pragma unroll
    for (int w = 0; w < 8; ++w) { const f32x4 o = *(const LAS f32x4*)(red + w * 32 + 4 * b);
#pragma unroll
        for (int c = 0; c < 4; ++c) am[c] = fmaxf(am[c], o[c]); }
#pragma unroll
    for (int c = 0; c < 4; ++c) inv[c] = am[c] > 0.f ? 127.0f / am[c] : 0.f;
    if (tid < 8) { f32x4 sc;
#pragma unroll
        for (int c = 0; c < 4; ++c) sc[c] = am[c] > 0.f ? am[c] * (1.0f / 127.0f) : 1.0f;
        *(f32x4*)(I.wscale + I.drow0 + 4 * b) = sc; }
#pragma unroll
    for (int p = 0; p < 4; ++p)
#pragma unroll
        for (int c = 0; c < 4; ++c)
            *(LAS unsigned*)(qT + (4 * b + c) * Q8_STRIDE + 4 * ((tid >> 3) + 64 * p)) = q8pack(v[4 * p][c] * inv[c], v[4 * p + 1][c] * inv[c], v[4 * p + 2][c] * inv[c], v[4 * p + 3][c] * inv[c]);
    LDS_WAIT(); __syncthreads();
}
__device__ __forceinline__ void q8_store(Frame& F, const Q8Item& I) {
    const LAS unsigned char* qT = F.lds + 1024;
#pragma unroll
    for (int j = 0; j < 4; ++j) { const int idx = F.tid + 512 * j, n = idx >> 6, ch = idx & 63;
        *(GAS u32x4*)(I.dst + (size_t)(I.drow0 + n) * 1024 + 16 * ch) = *(const LAS u32x4*)(qT + n * Q8_STRIDE + 16 * ch); }
    LDS_WAIT(); __syncthreads();
}
__device__ __forceinline__ void phase_convert(Frame& F, int l) {
    unsigned char* wb = F.ws() + WS_WB;
    { const float* w_in = F.in(IN_WIN) + (size_t)l * DM * INC; float* ws1 = (float*)(wb + WB_WS1); float* wsup = (float*)(wb + WB_WSUP);
      const float* wg = F.in(IN_WG) + (size_t)l * NEXP * DM * DE; const float* wu = F.in(IN_WU) + (size_t)l * NEXP * DM * DE;
#define Q8_ITEM(I, it) do { if ((it) < 192) I = Q8Item{w_in, INC, src1a(32 * (it)), (q8_t*)(wb + WB_1A), 32 * (it), ws1}; \
          else if ((it) < 288) I = Q8Item{w_in, INC, 6144 + 32 * ((it) - 192), (q8_t*)(wb + WB_1B), 32 * ((it) - 192), ws1 + 6144}; \
          else { const int r_ = (it) - 288, e_ = r_ >> 5, nb_ = r_ & 31, uq_ = nb_ >> 3, rb_ = nb_ & 7; \
              I = Q8Item{(rb_ < 4 ? wg : wu) + (size_t)e_ * DM * DE, DE, 128 * uq_ + 32 * (rb_ & 3), (q8_t*)(wb + WB_UP) + (size_t)e_ * 1024 * 1024, 32 * nb_, wsup + e_ * 1024}; } } while (0)
      constexpr int NQ8 = 192 + 96 + 512;
      f32x4 v[16]; Q8Item cur, nxt; int it = F.bid;
      if (it < NQ8) { Q8_ITEM(cur, it); q8_load(cur, F.tid, v); }
      for (; it < NQ8; it += F.G) {
          q8_quant(F, cur, v);
          const bool more = it + F.G < NQ8;
          if (more) { Q8_ITEM(nxt, it + F.G); q8_load(nxt, F.tid, v); }
          q8_store(F, cur);
          if (more) cur = nxt;
      }
#undef Q8_ITEM
    }
    LAS float* scr = (LAS float*)(F.lds + F.wave * 16384);
    const int gw = F.bid * 8 + F.wave, NGW = F.G * 8;
    constexpr int I_SQ = 32 * 16, I_C = 4 * 32, I_DN = 16 * 256;
    constexpr int NITEMS = 3 * I_SQ + I_C + I_DN;
    for (int it = gw; it < NITEMS; it += NGW) {
        int r = it;
        if (r < 3 * I_SQ) { const int which = r / I_SQ, q = r % I_SQ, nb = q >> 4, kb = q & 15;
            const float* src = (which == 0 ? F.in(IN_WA) : (which == 1 ? F.in(IN_WB) : F.in(IN_WO))) + (size_t)l * DM * DM;
            bf16_t* dst = (bf16_t*)(wb + (which == 0 ? WB_WA : (which == 1 ? WB_WBB : WB_WO)));
            tr_item(src, DM, 64 * kb, 32 * nb, dst, 1024, 32 * nb, 0, nullptr, scr, F.lane); continue; } r -= 3 * I_SQ;
        if (r < I_C) { const int g = r >> 5, q = r & 31, nb = q >> 2, kb = q & 3;
            tr_item(F.in(IN_WC) + ((size_t)l * 4 + g) * 65536, 256, 64 * kb, 32 * nb, (bf16_t*)(wb + WB_WC), 1024, 256 * g + 32 * nb, 256 * g, F.in(IN_CS) + (size_t)l * DM, scr, F.lane); continue; } r -= I_C;
        { const int e = r >> 8, q = r & 255, nb = q >> 3, kb = q & 7;
            tr_item(F.in(IN_WD) + ((size_t)l * NEXP + e) * DE * DM, DM, 64 * kb, 32 * nb, (bf16_t*)(wb + WB_DN) + (size_t)e * 1024 * 512, 512, 32 * nb, 0, nullptr, scr, F.lane); }
    }
    float* bias = (float*)(wb + WB_BIAS); const float* b_in = F.in(IN_BIN) + (size_t)l * INC;
    for (int i = F.bid * 512 + F.tid; i < INC; i += F.G * 512) bias[i] = b_in[i < 6144 ? src1a(i) : i];
    if (l == 0) {
        q8_t* xq = (q8_t*)(F.ws() + WS_XB); float* xs = (float*)(F.ws() + WS_XS);
        for (int row = gw; row < M; row += NGW) { const float* xr = F.in(IN_X) + (size_t)row * DM + 4 * F.lane; f32x4 v[4];
#pragma unroll
            for (int j = 0; j < 4; ++j) v[j] = *(const f32x4*)(xr + 256 * j);
            store_q8_row(xq + (size_t)row * DM, xs + row, v, F.lane); }
    }
}

constexpr int P2_IN_BYTES = 46 * 2048, P2_OUT_OFF = P2_IN_BYTES, P2_TILES = M / 16;
__device__ __forceinline__ void p2_stage(Frame& F, const bf16_t* PA, const unsigned char* zero, int tt) {
    const int grow0 = tt * 16, t0 = grow0 & (SEQ - 1);
#pragma unroll
    for (int i = 0; i < 12; ++i) { const int p = F.wave + 8 * i; if (p < 92) { const int r = p >> 1, half = p & 1;
        const unsigned char* src = (t0 - 30 + r >= 0) ? (const unsigned char*)(PA + (size_t)(grow0 - 30 + r) * LDPA) + half * 1024 : zero;
        __builtin_amdgcn_global_load_lds((const unsigned*)(src + F.lane * 16), (LAS unsigned*)(F.lds + p * 1024), 16, 0, 0); } }
}
__device__ __forceinline__ void phase_p2(Frame& F, int l) {
    const bf16_t* PA = (const bf16_t*)(F.ws() + WS_PA); bf16_t* OPS = (bf16_t*)(F.ws() + WS_OPS);
    const unsigned char* zero = F.ws() + WS_ZERO;
    const int tid = F.tid, lane = F.lane, wave = F.wave;
    LAS unsigned char* lds = F.lds;
    const int pc = tid & 127, rg = tid >> 7;
    const int pw = 2 << (pc >> 5);
    const int nrep = (((DUP_MASK) >> PH_P2) & 1) + 1;
    const int tpb = P2_TILES / F.G; const bool contig = tpb * F.G == P2_TILES;
#define P2_TILE(x) (contig ? ((x) % F.G) * tpb + ((x) / F.G) % tpb : ((x) & (P2_TILES - 1)))
    int tt_ = F.bid;
    if (tt_ < P2_TILES * nrep) p2_stage(F, PA, zero, P2_TILE(tt_));
    for (; tt_ < P2_TILES * nrep; tt_ += F.G) { const int tt = P2_TILE(tt_);
        const int grow0 = tt * 16, t0 = grow0 & (SEQ - 1);
        {   const int r0 = 4 * rg, tb = t0 + r0; const bf16_t* prow = PA + (size_t)(grow0 + r0) * LDPA + 8 * pc;
            u32x4 cu[6], cg[4], cc[19];
#pragma unroll
            for (int k = 0; k < 6; ++k) { cu[k] = (u32x4){0u, 0u, 0u, 0u}; if (tb - 2 + k >= 0) cu[k] = *(const u32x4*)(prow + 1024 + (ptrdiff_t)(k - 2) * LDPA); }
#pragma unroll
            for (int k = 0; k < 4; ++k) cg[k] = *(const u32x4*)(prow + 3072 + (size_t)k * LDPA);
#pragma unroll
            for (int k = 0; k < 19; ++k) { cc[k] = (u32x4){0u, 0u, 0u, 0u}; if (k >= 16 - pw && tb - 15 + k >= 0) cc[k] = *(const u32x4*)(prow + 2048 + (ptrdiff_t)(k - 15) * LDPA); }
            float wb3[3][8];
#pragma unroll
            for (int k = 0; k < 3; ++k) { const f32x4 a = *(const f32x4*)(F.in(IN_CBW) + ((size_t)l * 3 + k) * DM + 8 * pc), b = *(const f32x4*)(F.in(IN_CBW) + ((size_t)l * 3 + k) * DM + 8 * pc + 4);
#pragma unroll
                for (int e = 0; e < 4; ++e) { wb3[k][e] = a[e]; wb3[k][4 + e] = b[e]; } }
#pragma unroll
            for (int i = 0; i < 4; ++i) { float u0[8], u1[8], u2[8], gb[8]; unpack8(cu[i], u0); unpack8(cu[i + 1], u1); unpack8(cu[i + 2], u2); unpack8(cg[i], gb); float o[8];
#pragma unroll
                for (int e = 0; e < 8; ++e) o[e] = gb[e] * (wb3[0][e] * u0[e] + wb3[1][e] * u1[e] + wb3[2][e] * u2[e]);
                u32x4 wv; wv.x = pk2(o[0], o[1]); wv.y = pk2(o[2], o[3]); wv.z = pk2(o[4], o[5]); wv.w = pk2(o[6], o[7]);
                *(u32x4*)(OPS + (size_t)(grow0 + r0 + i) * LDOPS + OPS_SEG + 8 * pc) = wv; }
#pragma unroll
            for (int i = 0; i < 4; ++i) { float s[8], self[8], f[8]; unpack8(cc[15 + i], self);
#pragma unroll
                for (int e = 0; e < 8; ++e) s[e] = self[e];
#pragma unroll
                for (int j = 1; j < 16; ++j) { if (j < pw) { unpack8(cc[15 + i - j], f);
#pragma unroll
                    for (int e = 0; e < 8; ++e) s[e] += f[e]; } }
                const int t = tb + i; const float inv = 1.0f / (float)(t + 1 < pw ? t + 1 : pw);
                u32x4 wv; wv.x = pk2(s[0] * inv - self[0], s[1] * inv - self[1]); wv.y = pk2(s[2] * inv - self[2], s[3] * inv - self[3]);
                wv.z = pk2(s[4] * inv - self[4], s[5] * inv - self[5]); wv.w = pk2(s[6] * inv - self[6], s[7] * inv - self[7]);
                *(u32x4*)(OPS + (size_t)(grow0 + r0 + i) * LDOPS + 2 * OPS_SEG + 8 * pc) = wv; }
        }
        f32x2 w[31]; f32x2 cb;
        { const float* cw = F.in(IN_CAW) + (size_t)l * 31 * DM + 2 * tid; asm volatile("" : "+v"(cw));
#pragma unroll
          for (int k = 0; k < 31; ++k) w[k] = *(const f32x2*)(cw + (size_t)k * DM);
          cb = *(const f32x2*)(F.in(IN_CAB) + (size_t)l * DM + 2 * tid); }
        f32x4 lg[4], lb[4];
#pragma unroll
        for (int q = 0; q < 4; ++q) { lg[q] = *(const f32x4*)(F.in(IN_LAG) + (size_t)l * DM + 256 * q + 4 * lane); lb[q] = *(const f32x4*)(F.in(IN_LAB) + (size_t)l * DM + 256 * q + 4 * lane); }
        VM_WAIT(); __syncthreads();
        f32x2 v[46];
#pragma unroll
        for (int r = 0; r < 46; ++r) { const unsigned bits = *(const LAS unsigned*)(lds + r * 2048 + tid * 4); v[r].x = __uint_as_float(bits << 16); v[r].y = __uint_as_float(bits & 0xffff0000u); }
        LDS_WAIT(); __syncthreads();
        if (tt_ + F.G < P2_TILES * nrep) p2_stage(F, PA, zero, P2_TILE(tt_ + F.G));
#pragma unroll
        for (int o = 0; o < 16; ++o) { f32x2 s = cb;
#pragma unroll
            for (int k = 0; k < 31; ++k) s += w[k] * v[o + k];
            *(LAS f32x2*)(lds + P2_OUT_OFF + o * 4096 + tid * 8) = s; }
        LDS_WAIT(); __builtin_amdgcn_s_barrier(); asm volatile("" ::: "memory");
#pragma unroll
        for (int rr = 0; rr < 2; ++rr) { const int r = wave * 2 + rr; f32x4 x[4]; float s = 0.f;
#pragma unroll
            for (int q = 0; q < 4; ++q) { x[q] = *(const LAS f32x4*)(lds + P2_OUT_OFF + r * 4096 + q * 1024 + lane * 16); s += (x[q][0] + x[q][1]) + (x[q][2] + x[q][3]); }
            const float mean = wave_sum(s) * (1.f / DM); float s2 = 0.f;
#pragma unroll
            for (int q = 0; q < 4; ++q) { x[q] = x[q] - mean; s2 += (x[q][0] * x[q][0] + x[q][1] * x[q][1]) + (x[q][2] * x[q][2] + x[q][3] * x[q][3]); }
            const float rstd = 1.f / sqrtf(wave_sum(s2) * (1.f / DM) + LN_EPS);
            bf16_t* orow = OPS + (size_t)(grow0 + r) * LDOPS;
#pragma unroll
            for (int q = 0; q < 4; ++q) { f32x4 y = x[q] * rstd * lg[q] + lb[q]; u32x2 o; o.x = pk2(siluf_(y[0]), siluf_(y[1])); o.y = pk2(siluf_(y[2]), siluf_(y[3]));
                *(u32x2*)(orow + 256 * q + 4 * lane) = o; } }
    }
    VM_WAIT(); __syncthreads();
}

__device__ __forceinline__ void phase_ln1r(Frame& F, int l, bool dry) {
    LAS float* wr_t = (LAS float*)F.lds;
    LAS int* rinfo = (LAS int*)(F.lds + 65536);
    const int tid = F.tid, lane = F.lane, wave = F.wave;
    { const float* wrg = F.in(IN_WR);
      for (int i = tid; i < DM * 16 / 4; i += 512) { const f32x4 v = *(const f32x4*)(wrg + 4 * i); const int c = i >> 2, e0 = (i & 3) * 4;
#pragma unroll
          for (int e = 0; e < 4; ++e) wr_t[(e0 + e) * DM + c] = v[e]; } }
    f32x4 g[4], b[4];
#pragma unroll
    for (int j = 0; j < 4; ++j) { g[j] = *(const f32x4*)(F.in(IN_L1G) + (size_t)l * DM + 256 * j + 4 * lane); b[j] = *(const f32x4*)(F.in(IN_L1B) + (size_t)l * DM + 256 * j + 4 * lane); }
    float br[16];
#pragma unroll
    for (int e = 0; e < 16; ++e) br[e] = F.in(IN_BR)[e];
    __syncthreads();
    q8_t* XQ = (q8_t*)(F.ws() + (dry ? WS_OPS + 64 * MiB : WS_XB)); float* XS = (float*)(F.ws() + (dry ? WS_OPS + 80 * MiB : WS_XS)); bf16_t* X1B = (bf16_t*)(F.ws() + WS_OPS + (dry ? 32 * MiB : 0));
    const bf16_t* PB = (const bf16_t*)F.out();
    int* etok = (int*)(F.ws() + WS_ETOK); u32x4* tokinfo = (u32x4*)(F.ws() + WS_TOKINFO);
    for (int blk = F.bid; blk < M / 64; blk += F.G) {
        const bf16_t* xin = PB + ((size_t)blk * 64 + wave * 8) * DM + 4 * lane;
        u32x2 vn[4];
#pragma unroll
        for (int j = 0; j < 4; ++j) vn[j] = *(const u32x2*)(xin + 256 * j);
#pragma unroll 1
        for (int rr = 0; rr < 8; ++rr) { const int rl = wave * 8 + rr; const size_t row = (size_t)blk * 64 + rl;
            f32x4 v[4]; float s = 0.f;
#pragma unroll
            for (int j = 0; j < 4; ++j) { v[j] = (f32x4){bf2f(vn[j].x & 0xffffu), bf2f(vn[j].x >> 16), bf2f(vn[j].y & 0xffffu), bf2f(vn[j].y >> 16)}; s += (v[j][0] + v[j][1]) + (v[j][2] + v[j][3]); }
            { const int rn = rr < 7 ? rr + 1 : 7;
#pragma unroll
              for (int j = 0; j < 4; ++j) vn[j] = *(const u32x2*)(xin + (size_t)rn * DM + 256 * j); }
            const float mean = wave_sum(s) * (1.f / DM); float s2 = 0.f;
#pragma unroll
            for (int j = 0; j < 4; ++j) { v[j] = v[j] - mean; s2 += (v[j][0] * v[j][0] + v[j][1] * v[j][1]) + (v[j][2] * v[j][2] + v[j][3] * v[j][3]); }
            const float rstd = 1.f / sqrtf(wave_sum(s2) * (1.f / DM) + LN_EPS);
#pragma unroll
            for (int j = 0; j < 4; ++j) { v[j] = v[j] * rstd * g[j] + b[j]; u32x2 o; o.x = pk2(v[j][0], v[j][1]); o.y = pk2(v[j][2], v[j][3]); *(u32x2*)(X1B + row * DM + 256 * j + 4 * lane) = o; }
            store_q8_row(XQ + row * DM, XS + row, v, lane);
            float a[16];
            const LAS float* wrl = wr_t + 4 * lane; asm volatile("" : "+v"(wrl));
#pragma unroll
            for (int e = 0; e < 16; ++e) { float a0 = 0.f;
#pragma unroll
                for (int j = 0; j < 4; ++j) { const f32x4 wv = *(const LAS f32x4*)(wrl + e * DM + 256 * j); a0 += (v[j][0] * wv[0] + v[j][1] * wv[1]) + (v[j][2] * wv[2] + v[j][3] * wv[3]); }
                a[e] = a0; }
            {
                float t8[8], t4[4], t2[2], t1;
                const bool h0 = (lane & 1) != 0, h1 = (lane & 2) != 0;
#pragma unroll
                for (int i = 0; i < 8; ++i) { auto r = __builtin_amdgcn_permlane32_swap(__float_as_uint(a[i]), __float_as_uint(a[8 + i]), false, false); t8[i] = __uint_as_float(r[0]) + __uint_as_float(r[1]); }
#pragma unroll
                for (int i = 0; i < 4; ++i) { auto r = __builtin_amdgcn_permlane16_swap(__float_as_uint(t8[i]), __float_as_uint(t8[4 + i]), false, false); t4[i] = __uint_as_float(r[0]) + __uint_as_float(r[1]); }
#pragma unroll
                for (int i = 0; i < 2; ++i) t2[i] = (h0 ? t4[2 + i] : t4[i]) + dppf<DPP_XOR1>(h0 ? t4[i] : t4[2 + i]);
                t1 = (h1 ? t2[1] : t2[0]) + dppf<DPP_XOR2>(h1 ? t2[0] : t2[1]);
                t1 += dppf<DPP_ROR4>(t1); t1 += dppf<DPP_XOR8>(t1);
                float lgt[16];
#pragma unroll
                for (int e = 0; e < 16; ++e) lgt[e] = __uint_as_float((unsigned)__builtin_amdgcn_readlane((int)__float_as_uint(t1), 32 * (e >> 3) + 16 * ((e >> 2) & 1) + ((e >> 1) & 1) + 2 * (e & 1))) + br[e];
                const Route rt = route16(lgt);
                if (lane == 0) { rinfo[rl * 4 + 0] = rt.e1; rinfo[rl * 4 + 1] = rt.e2; rinfo[rl * 4 + 2] = (int)__float_as_uint(rt.p1); } }
        }
        __syncthreads();
        if (wave == 0 && !dry) {
            const int e1 = rinfo[lane * 4 + 0], e2 = rinfo[lane * 4 + 1]; const unsigned p1b = (unsigned)rinfo[lane * 4 + 2];
            const unsigned long long ltm = (1ull << lane) - 1ull;
            int mycnt = 0, r1 = 0, r2 = 0;
#pragma unroll
            for (int e = 0; e < 16; ++e) { const unsigned long long m1 = __ballot(e1 == e), m2 = __ballot(e2 == e); const int c1 = __popcll(m1), c2 = __popcll(m2);
                if (lane == e) mycnt = c1 + c2;
                if (e1 == e) r1 = __popcll(m1 & ltm);
                if (e2 == e) r2 = c1 + __popcll(m2 & ltm); }
            int base = 0;
            if (lane < 16) base = (int)__hip_atomic_fetch_add((unsigned*)(F.ctl() + CW_CNT + (l * 16 + lane) * 64), (unsigned)mycnt, __ATOMIC_RELAXED, __HIP_MEMORY_SCOPE_AGENT);
            const int pos1 = __shfl(base, e1) + r1, pos2 = __shfl(base, e2) + r2;
            const int tok = blk * 64 + lane;
            etok[e1 * M + pos1] = tok; etok[e2 * M + pos2] = tok;
            u32x4 ti; ti.x = (unsigned)(e1 | (e2 << 8)); ti.y = (unsigned)pos1; ti.z = (unsigned)pos2; ti.w = p1b; tokinfo[tok] = ti;
        }
        __syncthreads();
    }
}
__device__ __forceinline__ void load_pref(Frame& F, int l, volatile LAS int* pref) {
    if (F.tid == 0) { int p = 0;
        for (int e = 0; e < 16; ++e) { pref[e] = p; const unsigned c = __hip_atomic_load((unsigned*)(F.ctl() + CW_CNT + (l * 16 + e) * 64), __ATOMIC_RELAXED, __HIP_MEMORY_SCOPE_AGENT); p += (int)((c + 255u) >> 8); }
        pref[16] = p < MAX_RT ? p : MAX_RT; }
    __syncthreads();
}
__device__ __forceinline__ void phase_ln2(Frame& F, int l, bool dry) {
    volatile LAS int* pref = (volatile LAS int*)(F.lds + MISC_OFF + 64);
    load_pref(F, l, pref);
    const int lane = F.lane;
    f32x4 g[4], b[4];
#pragma unroll
    for (int j = 0; j < 4; ++j) { g[j] = *(const f32x4*)(F.in(IN_L2G) + (size_t)l * DM + 256 * j + 4 * lane); b[j] = *(const f32x4*)(F.in(IN_L2B) + (size_t)l * DM + 256 * j + 4 * lane); }
    const bf16_t* YS = (const bf16_t*)(F.ws() + WS_PA + PA_YS); q8_t* XQ = (q8_t*)(F.ws() + (dry ? WS_OPS + 64 * MiB : WS_XB)); float* XS = (float*)(F.ws() + (dry ? WS_OPS + 80 * MiB : WS_XS)); float* xo = dry ? (float*)(F.ws() + WS_OPS + 32 * MiB) : F.out(); const bf16_t* X1B = (const bf16_t*)(F.ws() + WS_OPS); const u32x4* tokinfo = (const u32x4*)(F.ws() + WS_TOKINFO);
    const int gw = F.bid * 8 + F.wave, NGW = F.G * 8;
    u32x2 nx[4], na[4], nb[4]; float np1 = 0.f; u32x4 tin = (u32x4){0u, 0u, 0u, 0u};
#define LN2_LOAD(r, ti) do { const int e1_ = (ti).x & 255, e2_ = ((ti).x >> 8) & 255; np1 = __uint_as_float((ti).w); \
        const bf16_t* xr_ = X1B + (size_t)(r) * DM + 4 * lane; const bf16_t* y1_ = YS + ((size_t)pref[e1_] * 256 + (ti).y) * DM + 4 * lane; const bf16_t* y2_ = YS + ((size_t)pref[e2_] * 256 + (ti).z) * DM + 4 * lane; \
        _Pragma("unroll") for (int j = 0; j < 4; ++j) { nx[j] = *(const u32x2*)(xr_ + 256 * j); na[j] = *(const u32x2*)(y1_ + 256 * j); nb[j] = *(const u32x2*)(y2_ + 256 * j); } } while (0)
    if (gw < M) { tin = tokinfo[gw]; LN2_LOAD(gw, tin); if (gw + NGW < M) tin = tokinfo[gw + NGW]; }
#pragma unroll 1
    for (int row = gw; row < M; row += NGW) {
        u32x2 cx[4], ca[4], cb[4]; const float p1 = np1, p2 = 1.0f - np1;
#pragma unroll
        for (int j = 0; j < 4; ++j) { cx[j] = nx[j]; ca[j] = na[j]; cb[j] = nb[j]; }
        if (row + NGW < M) { LN2_LOAD(row + NGW, tin); if (row + 2 * NGW < M) tin = tokinfo[row + 2 * NGW]; }
        f32x4 v[4]; float s = 0.f;
#pragma unroll
        for (int j = 0; j < 4; ++j) { const u32x2 xb = cx[j], ya = ca[j], yb = cb[j];
            v[j][0] = ALPHA * bf2f(xb.x & 0xffffu) + p1 * bf2f(ya.x & 0xffffu) + p2 * bf2f(yb.x & 0xffffu); v[j][1] = ALPHA * bf2f(xb.x >> 16) + p1 * bf2f(ya.x >> 16) + p2 * bf2f(yb.x >> 16);
            v[j][2] = ALPHA * bf2f(xb.y & 0xffffu) + p1 * bf2f(ya.y & 0xffffu) + p2 * bf2f(yb.y & 0xffffu); v[j][3] = ALPHA * bf2f(xb.y >> 16) + p1 * bf2f(ya.y >> 16) + p2 * bf2f(yb.y >> 16);
            s += (v[j][0] + v[j][1]) + (v[j][2] + v[j][3]); }
        const float mean = wave_sum(s) * (1.f / DM); float s2q = 0.f;
#pragma unroll
        for (int j = 0; j < 4; ++j) { v[j] = v[j] - mean; s2q += (v[j][0] * v[j][0] + v[j][1] * v[j][1]) + (v[j][2] * v[j][2] + v[j][3] * v[j][3]); }
        const float rstd = 1.f / sqrtf(wave_sum(s2q) * (1.f / DM) + LN_EPS);
#pragma unroll
        for (int j = 0; j < 4; ++j) v[j] = v[j] * rstd * g[j] + b[j];
        if (l + 1 < DEPTH) {
#pragma unroll
            for (int j = 0; j < 4; ++j) { u32x2 o; o.x = pk2(v[j][0], v[j][1]); o.y = pk2(v[j][2], v[j][3]); *(u32x2*)((bf16_t*)xo + (size_t)row * DM + 256 * j + 4 * lane) = o; }
            store_q8_row(XQ + (size_t)row * DM, XS + row, v, lane);
        } else {
#pragma unroll
            for (int j = 0; j < 4; ++j) *(f32x4*)(xo + (size_t)row * DM + 256 * j + 4 * lane) = v[j];
        }
    }
#undef LN2_LOAD
}

__global__ void __launch_bounds__(512, 2) mk_fwd(Args args) {
    extern __shared__ __attribute__((aligned(16))) unsigned char lds_raw[];
    Frame F;
    F.lds = (LAS unsigned char*)lds_raw; F.MISC = (volatile LAS unsigned*)(F.lds + MISC_OFF);
    F.tid = threadIdx.x; F.lane = F.tid & 63; F.wave = __builtin_amdgcn_readfirstlane(F.tid >> 6); F.G = gridDim.x; F.bid = blockIdx.x;
    const CAS Args* kap = (const CAS Args*)__builtin_amdgcn_kernarg_segment_ptr(); F.ap = kap;
    for (int u = F.tid; u < (LDS_BYTES - LDSCTL_OFF) / 4; u += 512) ((LAS unsigned*)(F.lds + LDSCTL_OFF))[u] = 0u;
    __syncthreads();
    const int lo = kap->ph_lo, hi = kap->ph_hi;
    XcdBarrier bar; bar.bar = (unsigned*)(F.ctl() + CW_BAR) + kap->region * XCD_BAR_WORDS; bar.x = 0; bar.st = nullptr;
    if (hi - lo > 1) bar = xcd_barrier_post((unsigned*)(F.ctl() + CW_BAR) + kap->region * XCD_BAR_WORDS, F.MISC + 8);
#ifndef PHASE_ENABLE
#define PHASE_ENABLE 0x3ff
#endif
#define DUP(id) for (int rep_ = 0; rep_ < (((DUP_MASK) >> (id)) & 1) + 1; ++rep_)
#define IN_(k) (((PHASE_ENABLE >> ((k) - p0)) & 1) && lo <= (k) && (k) < hi)
#define SEAM(k) do { if (lo <= (k) && (k) + 1 < hi) { XcdBarrier b_; b_.st = bar.st; b_.x = __builtin_amdgcn_readfirstlane(bar.x); b_.bar = (unsigned*)(F.ctl() + CW_BAR) + F.ap->region * XCD_BAR_WORDS; asm volatile("" : "+s"(b_.x)); xcd_barrier(b_); if ((DUP_MASK) & 0x400) xcd_barrier(b_); } } while (0)
    volatile LAS int* pref = (volatile LAS int*)(F.lds + MISC_OFF + 64);
#define REFRESH() asm volatile("" : "+s"(kap)); F.ap = kap; { int t_ = threadIdx.x, b_ = __builtin_amdgcn_readfirstlane((int)blockIdx.x), g_ = __builtin_amdgcn_readfirstlane((int)gridDim.x); asm volatile("" : "+v"(t_), "+s"(b_), "+s"(g_)); \
        F.tid = t_; F.lane = t_ & 63; F.wave = __builtin_amdgcn_readfirstlane(t_ >> 6); F.bid = b_; F.G = g_; } unsigned char* ws = F.ws(); unsigned char* wb = ws + WS_WB; (void)wb
#pragma unroll 1
    for (int l = 0; l < DEPTH; ++l) {
        const int p0 = l * NPH;
        if (IN_(p0 + PH_W)) { REFRESH(); DUP(PH_W) { phase_convert(F, l); __syncthreads(); } SEAM(p0 + PH_W); }
        if (IN_(p0 + PH_G1A)) { REFRESH();
            pg::ProbDenseQ P{(const char*)(ws + WS_XB), (const char*)(wb + WB_1A), 24, F.G, F.bid}; pg::EpiG1aQ E{(bf16_t*)(ws + WS_PA), (const float*)(wb + WB_BIAS), (const float*)(wb + WB_WS1), (const float*)(ws + WS_XS)};
            DUP(PH_G1A) pg::gemm_phase<pg::ProbDenseQ, pg::EpiG1aQ, true>(F.lds, P, E); SEAM(p0 + PH_G1A); }
        if (IN_(p0 + PH_P2)) { REFRESH(); phase_p2(F, l); SEAM(p0 + PH_P2); }
        if (IN_(p0 + PH_G1B)) { REFRESH();
            pg::ProbDenseQ P{(const char*)(ws + WS_XB), (const char*)(wb + WB_1B), 12, F.G, F.bid}; pg::EpiG1bQ E{(bf16_t*)(ws + WS_PA), (const float*)(wb + WB_BIAS) + 6144, (const float*)(wb + WB_WS1) + 6144, (const float*)(ws + WS_XS)};
            DUP(PH_G1B) pg::gemm_phase<pg::ProbDenseQ, pg::EpiG1bQ, true>(F.lds, P, E); SEAM(p0 + PH_G1B); }
        if (IN_(p0 + PH_P3)) { REFRESH();
            pg::ProbP3 P{(const char*)(ws + WS_OPS), (const char*)(wb + WB_WA), (const char*)(wb + WB_WBB), (const char*)(wb + WB_WC), F.G, F.bid}; pg::EpiP3 E{(const bf16_t*)(ws + WS_PA), (bf16_t*)(ws + WS_XB)};
            DUP(PH_P3) pg::gemm_phase<pg::ProbP3, pg::EpiP3, false>(F.lds, P, E); SEAM(p0 + PH_P3); }
        if (IN_(p0 + PH_P4)) { REFRESH();
            pg::ProbDense P{(const char*)(ws + WS_XB), (const char*)(wb + WB_WO), 4, F.G, F.bid}; pg::EpiP4 E{l == 0 ? F.in(IN_X) : (const float*)nullptr, (bf16_t*)F.out(), F.in(IN_BO) + (size_t)l * DM};
            pg::gemm_phase<pg::ProbDense, pg::EpiP4, false>(F.lds, P, E); if (((DUP_MASK) >> PH_P4) & 1) { if (l == 0) pg::gemm_phase<pg::ProbDense, pg::EpiP4, false>(F.lds, P, E); } SEAM(p0 + PH_P4); }
        if (IN_(p0 + PH_LN1)) { REFRESH(); if ((DUP_MASK >> PH_LN1) & 1) phase_ln1r(F, l, true); phase_ln1r(F, l, false); SEAM(p0 + PH_LN1); }
        if (IN_(p0 + PH_UP)) { REFRESH();
            load_pref(F, l, pref);
            typedef pg::ProbMoe<512, 512, 8, true, (((DUP_MASK) >> PH_UP) & 1) + 1, true> PU; PU P{(const char*)(ws + WS_XB), (const char*)(wb + WB_UP), (const int*)(ws + WS_ETOK), pref, F.G, F.bid};
            pg::EpiUpQ E{(bf16_t*)(ws + WS_PA + PA_H), (const float*)(wb + WB_WSUP), (const float*)(ws + WS_XS), (const int*)(ws + WS_ETOK)};
            pg::gemm_phase<PU, pg::EpiUpQ, true>(F.lds, P, E); SEAM(p0 + PH_UP); }
        if (IN_(p0 + PH_DN)) { REFRESH();
            load_pref(F, l, pref);
            typedef pg::ProbMoe<512, 512, 8, false> PD; PD P{(const char*)(ws + WS_PA + PA_H), (const char*)(wb + WB_DN), (const int*)(ws + WS_ETOK), pref, F.G, F.bid}; pg::EpiDown E{(bf16_t*)(ws + WS_PA + PA_YS)};
            DUP(PH_DN) pg::gemm_phase<PD, pg::EpiDown, true>(F.lds, P, E); SEAM(p0 + PH_DN); }
        if (IN_(p0 + PH_LN2)) { REFRESH(); if ((DUP_MASK >> PH_LN2) & 1) phase_ln2(F, l, true); phase_ln2(F, l, false); SEAM(p0 + PH_LN2); }
    }
#undef IN_
#undef SEAM
}

extern "C" void kernel_launch(void* const* d_in, const int* in_sizes, int n_in, void* d_out, int out_size, void* d_ws, size_t ws_size, hipStream_t stream) {
    static int grid = 0;
    if (grid == 0) {
        if (n_in != N_IN || in_sizes[0] != M * DM || out_size != M * DM || ws_size < WS_END) { fprintf(stderr, "kernel_launch: unexpected shapes (n_in %d, in0 %d, out %d, ws %zu)\n", n_in, n_in > 0 ? in_sizes[0] : -1, out_size, ws_size); grid = -1; return; }
        int dev = 0, cus = 0, per_cu = 0;
        if (hipGetDevice(&dev) != hipSuccess || hipDeviceGetAttribute(&cus, hipDeviceAttributeMultiprocessorCount, dev) != hipSuccess) { grid = -1; return; }
        if (hipFuncSetAttribute((const void*)mk_fwd, hipFuncAttributeMaxDynamicSharedMemorySize, LDS_BYTES) != hipSuccess) { fprintf(stderr, "kernel_launch: hipFuncSetAttribute failed\n"); grid = -1; return; }
        if (hipOccupancyMaxActiveBlocksPerMultiprocessor(&per_cu, (const void*)mk_fwd, 512, LDS_BYTES) != hipSuccess || per_cu < 1) fprintf(stderr, "kernel_launch: occupancy query says %d\n", per_cu);
        (void)hipGetLastError();
        grid = cus;
    }
    if (grid < 0) return;
    (void)hipMemsetAsync((char*)d_ws + WS_CTL, 0, ZERO_BYTES, stream);
    Args a{};
    for (int i = 0; i < N_IN; ++i) a.in[i] = (const float*)d_in[i];
    a.out = (float*)d_out; a.ws = (unsigned char*)d_ws;
    a.ph_lo = 0; a.ph_hi = DEPTH * NPH; a.region = 0;
    hipLaunchKernelGGL(mk_fwd, dim3(grid), dim3(512), LDS_BYTES, stream, a);
}
```
